# Optimizing an MI355X kernel written in HIP

```python
import jax, jax.numpy as jnp
from jax import lax
import numpy as np

D_MODEL = 1024
BATCH = 4
SEQ = 4096
DEPTH = 1
DEC_BATCH = 32
DEC_SEQ = 8
PAST_LEN = 8192
PAGE_SIZE = 128

SB_HEADS = 8
SB_HEAD_DIM = 64
SB_WIDTH = SB_HEADS * SB_HEAD_DIM
Q_BLOCK = 128
SB_BIAS_HI = -6.0
SB_BIAS_LO = -11.0
RET_HEADS = 4
RET_QK_DIM = 128
RET_V_DIM = 256
RET_QK_WIDTH = RET_HEADS * RET_QK_DIM
RET_V_WIDTH = RET_HEADS * RET_V_DIM
RET_CHUNK = 128
ROPE_BASE = 10000.0
D_FF = 2816
NORM_EPS = 1e-6
POOL_NUM = 5
POOL_DEN = 4
IN_WIDTH = 3 * SB_WIDTH + 2 * RET_QK_WIDTH + 2 * RET_V_WIDTH + 2 * D_MODEL

kernel_name = 'stickbreak_retention_hybrid_step'

F32 = jnp.float32


def rms_norm(x, g):
    xf = x.astype(F32)
    y = xf * lax.rsqrt(jnp.mean(xf * xf, axis=-1, keepdims=True) + NORM_EPS)
    return (y * g.astype(F32)).astype(x.dtype)


def swiglu(x, w_gu, w_down):
    g, u = jnp.split(x @ w_gu, 2, axis=-1)
    return (jax.nn.silu(g) * u) @ w_down


def rope(x, pos):
    half = x.shape[-1] // 2
    freq = ROPE_BASE ** (-jnp.arange(half, dtype=F32) / half)
    ang = pos.astype(F32)[:, None] * freq[None, :]
    cos = jnp.cos(ang)[None, :, None, :]
    sin = jnp.sin(ang)[None, :, None, :]
    xf = x.astype(F32)
    x1, x2 = xf[..., :half], xf[..., half:]
    return jnp.concatenate([x1 * cos - x2 * sin, x2 * cos + x1 * sin], axis=-1).astype(x.dtype)


def sb_block(q, k, v, q_pos, bias):
    z = jnp.einsum('bqhd,bkhd->bhqk', q.astype(F32), k.astype(F32)) * (SB_HEAD_DIM ** -0.5)
    z = z + bias.astype(F32)[None, :, None, None]
    k_pos = jnp.arange(k.shape[1])
    mask = k_pos[None, :] < q_pos[:, None]
    log_stay = jnp.where(mask, jax.nn.log_sigmoid(-z), 0.0)
    tail = lax.cumsum(log_stay, axis=3, reverse=True) - log_stay
    a = jnp.where(mask, jnp.exp(jax.nn.log_sigmoid(z) + tail), 0.0)
    return jnp.einsum('bhqk,bkhd->bqhd', a, v.astype(F32)).astype(q.dtype)


def stick_breaking(q, k, v, q_start, bias):
    B, Tq, H, D = q.shape
    qb = Q_BLOCK if Tq % Q_BLOCK == 0 else Tq
    nb = Tq // qb
    q_blocks = q.reshape(B, nb, qb, H, D).transpose(1, 0, 2, 3, 4)
    pos = (q_start + jnp.arange(Tq)).reshape(nb, qb)
    out = lax.map(lambda a: sb_block(a[0], k, v, a[1], bias), (q_blocks, pos))
    return out.transpose(1, 0, 2, 3, 4).reshape(B, Tq, H, D)


def retention(q, k, v, state):
    B, T, H, DK = q.shape
    DV = v.shape[-1]
    C = RET_CHUNK if T % RET_CHUNK == 0 else T
    n = T // C
    log_gamma = jnp.log1p(-jnp.exp2(-5.0 - jnp.arange(H, dtype=F32)))
    idx = jnp.arange(C, dtype=F32)
    diff = idx[:, None] - idx[None, :]
    decay_in = jnp.where(diff >= 0, jnp.exp(log_gamma[:, None, None] * jnp.maximum(diff, 0.0)), 0.0)
    decay_q = jnp.exp(log_gamma[:, None] * (idx + 1.0))[None, :, :, None]
    decay_k = jnp.exp(log_gamma[:, None] * (C - 1.0 - idx))[None, :, :, None]
    decay_c = jnp.exp(log_gamma * C)[None, :, None, None]

    def chunks(a):
        return a.astype(F32).reshape(B, n, C, H, a.shape[-1]).transpose(1, 0, 3, 2, 4)

    qc, kc, vc = chunks(q), chunks(k * (DK ** -0.5)), chunks(v)

    def step(S, inp):
        qi, ki, vi = inp
        inner = jnp.einsum('bhcd,bhsd->bhcs', qi, ki) * decay_in[None]
        o = jnp.einsum('bhcs,bhsv->bhcv', inner, vi) + jnp.einsum('bhcd,bhdv->bhcv', qi, S) * decay_q
        S = S * decay_c + jnp.einsum('bhsd,bhsv->bhdv', ki * decay_k, vi)
        return S, o

    S, o = lax.scan(step, state.astype(F32), (qc, kc, vc))
    o = o.transpose(1, 0, 3, 2, 4).reshape(B, T, H, DV)
    return o.astype(v.dtype), S.astype(state.dtype)


def mixer(u, k_past, v_past, ret_state, q_start, w_in, sb_bias, ret_gn_g, w_sb_out, w_ret_out, w_o):
    B, T, _ = u.shape
    sizes = [SB_WIDTH] * 3 + [RET_QK_WIDTH] * 2 + [RET_V_WIDTH] * 2 + [D_MODEL] * 2
    cuts = [int(c) for c in np.cumsum(sizes)[:-1]]
    q_sb, k_sb, v_sb, q_r, k_r, v_r, g_r, a_sb, a_r = jnp.split(u @ w_in, cuts, axis=-1)
    pos = q_start + jnp.arange(T)
    q_sb = q_sb.reshape(B, T, SB_HEADS, SB_HEAD_DIM)
    k_sb = k_sb.reshape(B, T, SB_HEADS, SB_HEAD_DIM)
    v_sb = v_sb.reshape(B, T, SB_HEADS, SB_HEAD_DIM)
    if k_past is None:
        keys, vals = k_sb, v_sb
    else:
        keys = jnp.concatenate([k_past.astype(k_sb.dtype), k_sb], axis=1)
        vals = jnp.concatenate([v_past.astype(v_sb.dtype), v_sb], axis=1)
    o_sb = stick_breaking(q_sb, keys, vals, q_start, sb_bias).reshape(B, T, SB_WIDTH)
    q_r = rope(q_r.reshape(B, T, RET_HEADS, RET_QK_DIM), pos)
    k_r = rope(k_r.reshape(B, T, RET_HEADS, RET_QK_DIM), pos)
    v_r = v_r.reshape(B, T, RET_HEADS, RET_V_DIM)
    o_r, new_state = retention(q_r, k_r, v_r, ret_state)
    o_rf = o_r.astype(F32)
    o_rf = o_rf * lax.rsqrt(jnp.mean(o_rf * o_rf, axis=-1, keepdims=True) + NORM_EPS)
    o_r = (o_rf.reshape(B, T, RET_V_WIDTH) * ret_gn_g.astype(F32)).astype(u.dtype)
    o_r = jax.nn.silu(g_r) * o_r
    m = jax.nn.sigmoid(a_sb) * (o_sb @ w_sb_out) + jax.nn.sigmoid(a_r) * (o_r @ w_ret_out)
    return m @ w_o, k_sb, v_sb, new_state


def layer(x, k_past, v_past, ret_state, q_start, p):
    (g_f1_pre, w_f1_gu, w_f1_down, g_f1_post, g_m_pre, w_in, sb_bias, ret_gn_g, w_sb_out, w_ret_out, w_o,
     g_m_post, g_f2_pre, w_f2_gu, w_f2_down, g_f2_post) = p
    h = x + 0.5 * rms_norm(swiglu(rms_norm(x, g_f1_pre), w_f1_gu, w_f1_down), g_f1_post)
    mix, k_new, v_new, s_new = mixer(rms_norm(h, g_m_pre), k_past, v_past, ret_state, q_start,
                                     w_in, sb_bias, ret_gn_g, w_sb_out, w_ret_out, w_o)
    h = h + rms_norm(mix, g_m_post)
    h = h + 0.5 * rms_norm(swiglu(rms_norm(h, g_f2_pre), w_f2_gu, w_f2_down), g_f2_post)
    return h, k_new, v_new, s_new


def setup_inputs(seed: int = 0) -> dict:
    key = jax.random.key(seed)
    ks = jax.random.split(key, 32)
    n_pages = PAST_LEN // PAGE_SIZE
    n_used = DEC_BATCH * n_pages
    n_pool = (n_used * POOL_NUM) // POOL_DEN

    def w(k, shape, fan_in):
        return jax.random.normal(k, shape, F32) * (fan_in ** -0.5)

    def gain(k, dim):
        return 1.0 + 0.02 * jax.random.normal(k, (DEPTH, dim), F32)

    page_table = jax.random.permutation(ks[5], n_pool)[:n_used].reshape(DEC_BATCH, n_pages).astype(jnp.int32)
    sb_bias = (jnp.linspace(SB_BIAS_HI, SB_BIAS_LO, SB_HEADS, dtype=F32)[None, :]
               + 0.1 * jax.random.normal(ks[21], (DEPTH, SB_HEADS), F32))
    return {
        'x_prompt': jax.random.normal(ks[0], (BATCH, SEQ, D_MODEL), F32),
        'x_sample': jax.random.normal(ks[1], (DEC_BATCH, DEC_SEQ, D_MODEL), F32),
        'cache_k': jax.random.normal(ks[2], (DEPTH, n_pool, PAGE_SIZE, SB_HEADS, SB_HEAD_DIM), F32),
        'cache_v': jax.random.normal(ks[3], (DEPTH, n_pool, PAGE_SIZE, SB_HEADS, SB_HEAD_DIM), F32),
        'state_ret': jax.random.normal(ks[4], (DEPTH, DEC_BATCH, RET_HEADS, RET_QK_DIM, RET_V_DIM), F32),
        'page_table': page_table,
        'g_ffn1_pre': gain(ks[6], D_MODEL),
        'w_ffn1_gu': w(ks[7], (DEPTH, D_MODEL, 2 * D_FF), D_MODEL),
        'w_ffn1_down': w(ks[8], (DEPTH, D_FF, D_MODEL), D_FF),
        'g_ffn1_post': gain(ks[9], D_MODEL),
        'g_mix_pre': gain(ks[10], D_MODEL),
        'w_in': w(ks[11], (DEPTH, D_MODEL, IN_WIDTH), D_MODEL),
        'sb_bias': sb_bias,
        'ret_gn_g': gain(ks[12], RET_V_WIDTH),
        'w_sb_out': w(ks[13], (DEPTH, SB_WIDTH, D_MODEL), SB_WIDTH),
        'w_ret_out': w(ks[14], (DEPTH, RET_V_WIDTH, D_MODEL), RET_V_WIDTH),
        'w_o': w(ks[15], (DEPTH, D_MODEL, D_MODEL), D_MODEL),
        'g_mix_post': gain(ks[16], D_MODEL),
        'g_ffn2_pre': gain(ks[17], D_MODEL),
        'w_ffn2_gu': w(ks[18], (DEPTH, D_MODEL, 2 * D_FF), D_MODEL),
        'w_ffn2_down': w(ks[19], (DEPTH, D_FF, D_MODEL), D_FF),
        'g_ffn2_post': gain(ks[20], D_MODEL),
    }


def reference(x_prompt, x_sample, cache_k, cache_v, state_ret, page_table,
              g_ffn1_pre, w_ffn1_gu, w_ffn1_down, g_ffn1_post, g_mix_pre, w_in, sb_bias, ret_gn_g,
              w_sb_out, w_ret_out, w_o, g_mix_post, g_ffn2_pre, w_ffn2_gu, w_ffn2_down, g_ffn2_post):
    n_seq, n_pages = page_table.shape
    past_len = n_pages * PAGE_SIZE
    hp, hs = x_prompt, x_sample
    kp_l, vp_l, sp_l, ks_l, vs_l, ss_l = [], [], [], [], [], []
    for l in range(DEPTH):
        p = (g_ffn1_pre[l], w_ffn1_gu[l], w_ffn1_down[l], g_ffn1_post[l], g_mix_pre[l], w_in[l],
             sb_bias[l], ret_gn_g[l], w_sb_out[l], w_ret_out[l], w_o[l], g_mix_post[l], g_ffn2_pre[l],
             w_ffn2_gu[l], w_ffn2_down[l], g_ffn2_post[l])
        s0 = jnp.zeros((hp.shape[0], RET_HEADS, RET_QK_DIM, RET_V_DIM), state_ret.dtype)
        hp, kp, vp, sp = layer(hp, None, None, s0, 0, p)
        k_past = cache_k[l][page_table].reshape(n_seq, past_len, SB_HEADS, SB_HEAD_DIM)
        v_past = cache_v[l][page_table].reshape(n_seq, past_len, SB_HEADS, SB_HEAD_DIM)
        hs, kn, vn, sn = layer(hs, k_past, v_past, state_ret[l], past_len, p)
        kp_l.append(kp); vp_l.append(vp); sp_l.append(sp)
        ks_l.append(kn); vs_l.append(vn); ss_l.append(sn)
    return (hp, hs, jnp.stack(kp_l), jnp.stack(vp_l), jnp.stack(sp_l),
            jnp.stack(ks_l), jnp.stack(vs_l), jnp.stack(ss_l))
```

```cpp
#include <hip/hip_runtime.h>
#include <cstdio>
#include <cstdint>
#ifndef PROBE_REP
#define PROBE_REP -1
#endif

constexpr int DM = 1024, NBATCH = 4, SEQ = 4096, MP = NBATCH * SEQ, DECB = 32, DECS = 8, MS = DECB * DECS, MT = MP + MS;
constexpr int PAST = 8192, PAGE = 128, NPAGES = PAST / PAGE, NPOOL = 2560;
constexpr int SBH = 8, SBD = 64, SBW = 512, RH = 4, RDK = 128, RDV = 256, RQW = 512, RVW = 1024, DFF = 2816, INW = 6656;
constexpr float NORM_EPS = 1e-6f;
constexpr float LOG2E = 1.4426950408889634f;
constexpr size_t OUT_YP = 0, OUT_YS = OUT_YP + (size_t)MP * DM, OUT_KP = OUT_YS + (size_t)MS * DM, OUT_VP = OUT_KP + (size_t)MP * SBW, OUT_SP = OUT_VP + (size_t)MP * SBW,
                 OUT_KS = OUT_SP + (size_t)NBATCH * RH * RDK * RDV, OUT_VS = OUT_KS + (size_t)MS * SBW, OUT_SS = OUT_VS + (size_t)MS * SBW, OUT_END = OUT_SS + (size_t)DECB * RH * RDK * RDV;

#define GAS __attribute__((address_space(1)))
#define LAS __attribute__((address_space(3)))
typedef unsigned short bf16_t;
typedef short bf16x8 __attribute__((ext_vector_type(8)));
typedef short s16x4 __attribute__((ext_vector_type(4)));
typedef float f32x4 __attribute__((ext_vector_type(4)));
typedef float f32x2 __attribute__((ext_vector_type(2)));
typedef float f32x16 __attribute__((ext_vector_type(16)));
typedef unsigned u32x4 __attribute__((ext_vector_type(4)));
typedef unsigned u32x2 __attribute__((ext_vector_type(2)));
typedef GAS unsigned gu32;

__device__ __forceinline__ unsigned cvt_pk_bf16(float lo, float hi) { unsigned r; asm volatile("v_cvt_pk_bf16_f32 %0, %1, %2" : "=v"(r) : "v"(lo), "v"(hi)); return r; }
__device__ __forceinline__ float bf_lo(unsigned w) { return __uint_as_float(w << 16); }
__device__ __forceinline__ float bf_hi(unsigned w) { return __uint_as_float(w & 0xffff0000u); }
__device__ __forceinline__ float fast_rcp(float x) { return __builtin_amdgcn_rcpf(x); }
__device__ __forceinline__ float fast_exp2(float x) { return __builtin_amdgcn_exp2f(x); }
__device__ __forceinline__ float sigmoidf_(float x) { return fast_rcp(1.0f + fast_exp2(-x * LOG2E)); }
__device__ __forceinline__ float siluf_(float x) { return x * sigmoidf_(x); }

namespace pg8 {
constexpr int BM = 256, BK = 64, HALF = 128, HTB = HALF * BK * 2, STAGE_BYTES = 8 * HTB, NXCD = 8, WGM = 8;
__host__ __device__ __forceinline__ int lds_byte(int r, int c) { const int st = (r >> 4) * 2 + (c >> 5), rr = r & 15, cc = c & 31, ob = rr * 64 + cc * 2; return st * 1024 + (ob ^ (((ob >> 9) & 1) << 5)); }
__host__ __device__ __forceinline__ void stage_rc(int b, int& R, int& C) { const int st = b / 1024, sb = b % 1024, swz = sb ^ (((sb >> 9) & 1) << 5); R = (st >> 1) * 16 + swz / 64; C = (st & 1) * 32 + (swz % 64) / 2; }
__host__ __device__ __forceinline__ int perm32(int rho) { const int n = rho >> 4, i = rho & 15; return 8 * (i >> 2) + 4 * n + (i & 3); }

struct Unit { int pm, pn, kt0, nt; };
struct Gemm { const bf16_t* A; const bf16_t* Bt; int K; };

struct TileOrder {
    int nM, nN, nwg, G, c, nt;
    __device__ void init(int nM_, int nN_, int nt_, int G_, int c_) { nM = nM_; nN = nN_; nwg = nM * nN; G = G_; c = c_; nt = nt_; }
    __device__ bool next(int i, Unit& u) const {
        const long L = (long)i * G + c; if (L >= nwg) return false;
        int wgid = (int)L; { const int q = nwg / NXCD, r = nwg % NXCD, xcd = wgid % NXCD, off = wgid / NXCD; wgid = (xcd < r ? xcd * (q + 1) : r * (q + 1) + (xcd - r) * q) + off; }
        const int nig = WGM * nN, gid = wgid / nig, fm = gid * WGM, gsz = (nM - fm) < WGM ? (nM - fm) : WGM;
        u.pm = fm + ((wgid % nig) % gsz); u.pn = (wgid % nig) / gsz; u.kt0 = 0; u.nt = nt; return true;
    }
};

struct PanelOrder {
    TileOrder T; int nex, sl;
    __device__ void init(int nt_, int sl_, int G_, int c_) { T.init(64, 4, nt_, G_, c_); sl = sl_; nex = 4 * (nt_ / sl_); }
    __device__ bool next(int i, Unit& u) const {
        long L = (long)i * T.G + T.c; if (L < 256) return T.next(i, u);
        L -= 256; if (L >= nex) return false;
        u.pm = 64; u.pn = (int)(L & 3); u.kt0 = (int)(L >> 2) * sl; u.nt = sl; return true;
    }
};

template <class Epi, class Sched, bool ALIGN_EPI, bool SP2>
__device__ __forceinline__ void gemm_phase(LAS unsigned char* lds, const Gemm g, const Sched& S, const Epi& E) {
    const int tid = threadIdx.x, wid = __builtin_amdgcn_readfirstlane(tid >> 6), lane = tid & 63, wr = wid >> 2, wc = wid & 3, fr = lane & 15, fq = lane >> 4;
    const int K = g.K;
    unsigned voffA[2], voffB[2];
#pragma unroll
    for (int i = 0; i < 2; ++i) { int R, C; stage_rc(tid * 16 + i * 8192, R, C); const int Rb = (R & ~31) + perm32(R & 31);
        voffA[i] = (unsigned)(R * K + C) * 2u; voffB[i] = (unsigned)(Rb * K + C) * 2u; }
    const size_t kstep = (size_t)(BK * 2);
    const size_t hstep = (size_t)HALF * K * 2;
    const size_t tstep = 2 * hstep;
    const unsigned ldsw = (unsigned)wid * 1024u;
    const int aoff = lds_byte(wr * 64 + fr, fq * 8), boff = lds_byte(wc * 32 + fr, fq * 8);
#define PG8_SA(b, h) (((b) * 2 + (h)) * HTB)
#define PG8_SB(b, h) ((4 + (b) * 2 + (h)) * HTB)
#define PG8_STAGE(bufoff, gbase, voff) do { _Pragma("unroll") for (int _i = 0; _i < 2; ++_i) \
        __builtin_amdgcn_global_load_lds((const unsigned*)((const char*)(gbase) + (voff)[_i]), (LAS unsigned*)(lds + (bufoff) + ldsw + _i * 8192), 16, 0, 0); } while (0)
#define PG8_LDA(dst, b, h) do { _Pragma("unroll") for (int m = 0; m < 4; ++m) _Pragma("unroll") for (int k = 0; k < 2; ++k) dst[m][k] = *(const LAS bf16x8*)(lds + PG8_SA(b, h) + aoff + m * 2048 + k * 1024); } while (0)
#define PG8_LDB(dst, b, h) do { _Pragma("unroll") for (int n = 0; n < 2; ++n) _Pragma("unroll") for (int k = 0; k < 2; ++k) dst[n][k] = *(const LAS bf16x8*)(lds + PG8_SB(b, h) + boff + n * 2048 + k * 1024); } while (0)
#define PG8_MMA(ai, bj, At, Bt) do { __builtin_amdgcn_s_setprio(1); _Pragma("unroll") for (int m = 0; m < 4; ++m) _Pragma("unroll") for (int n = 0; n < 2; ++n) _Pragma("unroll") for (int k = 0; k < 2; ++k) \
        acc[ai][bj][m][n] = __builtin_amdgcn_mfma_f32_16x16x32_bf16(Bt[n][k], At[m][k], acc[ai][bj][m][n], 0, 0, 0); __builtin_amdgcn_s_setprio(0); } while (0)
#define PG8_WAIT_V(n) asm volatile("s_waitcnt vmcnt(" #n ")" ::: "memory")
#define PG8_WAIT_L(n) asm volatile("s_waitcnt lgkmcnt(" #n ")" ::: "memory")
#define PG8_BAR __builtin_amdgcn_s_barrier()
#define PG8_SCHED __builtin_amdgcn_sched_barrier(0)
    Unit cur, nxt; int ui = 0;
    if (!S.next(0, cur)) return;
    f32x4 acc[2][2][4][2];
#pragma unroll
    for (int a = 0; a < 2; ++a)
#pragma unroll
        for (int b = 0; b < 2; ++b)
#pragma unroll
            for (int m = 0; m < 4; ++m)
#pragma unroll
                for (int n = 0; n < 2; ++n) acc[a][b][m][n] = (f32x4){0.f, 0.f, 0.f, 0.f};
    bf16x8 At[4][2], B0[2][2], B1[2][2];
    const char* cA = (const char*)g.A + (size_t)cur.pm * tstep + (size_t)cur.kt0 * kstep; const char* cB = (const char*)g.Bt + (size_t)cur.pn * tstep + (size_t)cur.kt0 * kstep;
    if constexpr (SP2) {
        PG8_STAGE(PG8_SB(0, 0), cB, voffB); PG8_STAGE(PG8_SB(0, 1), cB + hstep, voffB); PG8_STAGE(PG8_SA(0, 0), cA, voffA); PG8_STAGE(PG8_SA(0, 1), cA + hstep, voffA);
        if (wr == 1) PG8_BAR;
        PG8_WAIT_V(2); PG8_BAR;
        PG8_STAGE(PG8_SB(1, 0), cB + kstep, voffB); PG8_STAGE(PG8_SA(1, 0), cA + kstep, voffA); PG8_STAGE(PG8_SB(1, 1), cB + hstep + kstep, voffB);
        PG8_WAIT_V(6); PG8_BAR;
    } else {
        PG8_STAGE(PG8_SB(0, 0), cB, voffB); PG8_STAGE(PG8_SA(0, 0), cA, voffA); PG8_STAGE(PG8_SB(0, 1), cB + hstep, voffB); PG8_STAGE(PG8_SA(0, 1), cA + hstep, voffA);
        if (wr == 1) PG8_BAR;
        PG8_WAIT_V(4); PG8_BAR;
        PG8_STAGE(PG8_SB(1, 0), cB + kstep, voffB); PG8_STAGE(PG8_SA(1, 0), cA + kstep, voffA); PG8_STAGE(PG8_SB(1, 1), cB + hstep + kstep, voffB);
        PG8_WAIT_V(6); PG8_BAR;
    }
    for (;;) {
        const bool has_next = S.next(ui + 1, nxt);
        const char* nA = has_next ? (const char*)g.A + (size_t)nxt.pm * tstep + (size_t)nxt.kt0 * kstep : cA; const char* nB = has_next ? (const char*)g.Bt + (size_t)nxt.pn * tstep + (size_t)nxt.kt0 * kstep : cB;
        const int nt = cur.nt;
        for (int t = 0; t < nt; t += 2) {
            const bool last = (t == nt - 2);
            const char* a1 = cA + (size_t)(t + 1) * kstep;
            const char* a2 = last ? nA : cA + (size_t)(t + 2) * kstep; const char* b2 = last ? nB : cB + (size_t)(t + 2) * kstep;
            const char* a3 = a2 + kstep; const char* b3 = b2 + kstep;
            if constexpr (SP2) {
            PG8_LDB(B0, 0, 0); PG8_LDB(B1, 0, 1); PG8_SCHED; PG8_LDA(At, 0, 0); PG8_STAGE(PG8_SA(1, 1), a1 + hstep, voffA);
            PG8_WAIT_V(8); PG8_WAIT_L(0); PG8_BAR; PG8_MMA(0, 0, At, B0); PG8_MMA(0, 1, At, B1); PG8_BAR; PG8_SCHED;
            PG8_LDA(At, 0, 1); PG8_STAGE(PG8_SB(0, 0), b2, voffB); PG8_STAGE(PG8_SB(0, 1), b2 + hstep, voffB); PG8_STAGE(PG8_SA(0, 0), a2, voffA);
            PG8_WAIT_V(8); PG8_WAIT_L(0); PG8_BAR; PG8_MMA(1, 0, At, B0); PG8_MMA(1, 1, At, B1); PG8_BAR; PG8_SCHED;
            PG8_LDB(B0, 1, 0); PG8_LDB(B1, 1, 1); PG8_SCHED; PG8_LDA(At, 1, 0); PG8_STAGE(PG8_SA(0, 1), a2 + hstep, voffA);
            PG8_WAIT_V(8); PG8_WAIT_L(0); PG8_BAR; PG8_MMA(0, 0, At, B0); PG8_MMA(0, 1, At, B1); PG8_BAR; PG8_SCHED;
            PG8_LDA(At, 1, 1); PG8_STAGE(PG8_SB(1, 0), b3, voffB); PG8_STAGE(PG8_SB(1, 1), b3 + hstep, voffB); PG8_STAGE(PG8_SA(1, 0), a3, voffA);
            PG8_WAIT_V(8); PG8_WAIT_L(0); PG8_BAR; PG8_MMA(1, 0, At, B0); PG8_MMA(1, 1, At, B1); PG8_BAR; PG8_SCHED;
            } else {
            PG8_LDB(B0, 0, 0); PG8_SCHED; PG8_LDA(At, 0, 0); PG8_STAGE(PG8_SA(1, 1), a1 + hstep, voffA);
            PG8_WAIT_L(8); PG8_BAR; PG8_WAIT_L(0); PG8_MMA(0, 0, At, B0); PG8_BAR; PG8_SCHED;
            PG8_LDB(B1, 0, 1); PG8_STAGE(PG8_SB(0, 0), b2, voffB);
            PG8_BAR; PG8_WAIT_L(0); PG8_MMA(0, 1, At, B1); PG8_BAR;
            PG8_LDA(At, 0, 1); PG8_STAGE(PG8_SA(0, 0), a2, voffA);
            PG8_BAR; PG8_WAIT_L(0); PG8_MMA(1, 0, At, B0); PG8_BAR; PG8_SCHED;
            PG8_STAGE(PG8_SB(0, 1), b2 + hstep, voffB);
            PG8_WAIT_V(6); PG8_BAR; PG8_MMA(1, 1, At, B1); PG8_BAR;
            PG8_LDB(B0, 1, 0); PG8_SCHED; PG8_LDA(At, 1, 0); PG8_STAGE(PG8_SA(0, 1), a2 + hstep, voffA);
            PG8_WAIT_L(8); PG8_BAR; PG8_WAIT_L(0); PG8_MMA(0, 0, At, B0); PG8_BAR; PG8_SCHED;
            PG8_LDB(B1, 1, 1); PG8_STAGE(PG8_SB(1, 0), b3, voffB);
            PG8_BAR; PG8_WAIT_L(0); PG8_MMA(0, 1, At, B1); PG8_BAR;
            PG8_LDA(At, 1, 1); PG8_STAGE(PG8_SA(1, 0), a3, voffA);
            PG8_BAR; PG8_WAIT_L(0); PG8_MMA(1, 0, At, B0); PG8_BAR; PG8_SCHED;
            PG8_STAGE(PG8_SB(1, 1), b3 + hstep, voffB);
            PG8_WAIT_V(6); PG8_BAR; PG8_MMA(1, 1, At, B1); PG8_BAR;
            }
        }
        if constexpr (ALIGN_EPI) { if (wr == 0) PG8_BAR; }
        E(acc, cur, wr, wc, fr, fq);
        if (!has_next) break;
#pragma unroll
        for (int a = 0; a < 2; ++a)
#pragma unroll
            for (int b = 0; b < 2; ++b)
#pragma unroll
                for (int m = 0; m < 4; ++m)
#pragma unroll
                    for (int n = 0; n < 2; ++n) acc[a][b][m][n] = (f32x4){0.f, 0.f, 0.f, 0.f};
        cur = nxt; cA = nA; cB = nB; ++ui;
        if constexpr (ALIGN_EPI) { if (wr == 1) PG8_BAR; }
    }
    PG8_WAIT_V(0);
    if constexpr (!ALIGN_EPI) { if (wr == 0) PG8_BAR; }
    PG8_BAR;
#undef PG8_SA
#undef PG8_SB
#undef PG8_STAGE
#undef PG8_LDA
#undef PG8_LDB
#undef PG8_MMA
#undef PG8_WAIT_V
#undef PG8_WAIT_L
#undef PG8_BAR
#undef PG8_SCHED
}
}

constexpr size_t MiB = 1u << 20;
constexpr size_t WS_CTL = 0, CTL_ZERO_BYTES = 1 * MiB;
constexpr size_t WS_TAB = 1 * MiB;
constexpr size_t WS_WGU1 = 4 * MiB;
constexpr size_t WS_WDN1 = 15 * MiB;
constexpr size_t WS_WIN = 21 * MiB;
constexpr size_t WS_WSBO = 34 * MiB;
constexpr size_t WS_WRO = 35 * MiB;
constexpr size_t WS_WO = 37 * MiB;
constexpr size_t WS_WGU2 = 39 * MiB;
constexpr size_t WS_WDN2 = 50 * MiB;
constexpr size_t WS_XN = 56 * MiB;
constexpr size_t WS_ACT = 90 * MiB;
constexpr size_t WS_F = 180 * MiB;
constexpr size_t WS_H = 214 * MiB;
constexpr size_t WS_QSB = 280 * MiB, WS_KSB = 297 * MiB, WS_VSB = 314 * MiB;
constexpr size_t WS_QD = 331 * MiB, WS_KI = 348 * MiB;
constexpr size_t WS_VR = 365 * MiB, WS_GR = 398 * MiB, WS_GA = 431 * MiB, WS_GB = 464 * MiB;
constexpr size_t WS_OSB = 497 * MiB;
constexpr size_t WS_OR = 514 * MiB;
constexpr size_t WS_T1 = 547 * MiB;
constexpr size_t WS_MB = 580 * MiB;
constexpr size_t WS_SPT = 613 * MiB;
constexpr size_t WS_DPART = 646 * MiB;
constexpr size_t WS_SLAB = 700 * MiB;
constexpr size_t WS_END = 720 * MiB;

constexpr int CW_BAR = 4096, CW_Q = 8192;

constexpr int RING_OFF = 0, RING_BYTES = 131072;
constexpr int LDSCTL_OFF = RING_BYTES, MISC_OFF = LDSCTL_OFF + 320;
constexpr int LDS_BYTES = 147456;
constexpr int NWAVES = 8;

#define RLX_AGENT __ATOMIC_RELAXED, __HIP_MEMORY_SCOPE_AGENT
#define LDS_WAIT() asm volatile("s_waitcnt lgkmcnt(0)" ::: "memory")
#define VM_WAIT() asm volatile("s_waitcnt vmcnt(0)" ::: "memory")

#define XB_TMO      128
#define XB_XCNT(j)  (256  + 64 * (j))
#define XB_XSUB(j)  (1280 + 64 * (j))
#define XB_XGEN(j)  (2304 + 64 * (j))
#define XB_TOP      3328
#define XB_TOPGEN   3392
#define XCD_BAR_WORDS 3456
#define XB_SPIN_CAP (1u << 18)
__device__ __forceinline__ unsigned xb_ld(unsigned* p)              { return __hip_atomic_load(p, __ATOMIC_RELAXED, __HIP_MEMORY_SCOPE_AGENT); }
__device__ __forceinline__ unsigned xb_add(unsigned* p, unsigned v) { return __hip_atomic_fetch_add(p, v, __ATOMIC_RELAXED, __HIP_MEMORY_SCOPE_AGENT); }
__device__ __forceinline__ unsigned xb_xcc_id() { return (unsigned)__builtin_amdgcn_s_getreg((3 << 11) | 20) & 0xFu; }
#define XB_SPIN(cond, bar) do { unsigned _sp = 0; while (cond) { __builtin_amdgcn_s_sleep(1); \
    if ((++_sp & 255u) == 0u) { if (xb_ld(&(bar)[XB_TMO])) break; if (_sp > XB_SPIN_CAP) { atomicAdd(&(bar)[XB_TMO], 1u); break; } } } } while (0)
struct XcdBarrier { unsigned* bar; unsigned x; volatile LAS unsigned* st; };
__device__ __forceinline__ XcdBarrier xcd_barrier_post(unsigned* bar, volatile LAS unsigned* st) {
    XcdBarrier b; b.bar = bar; b.x = xb_xcc_id(); b.st = st;
    if (threadIdx.x == 0) (void)xb_add(&bar[XB_XCNT(b.x)], 1u);
    return b;
}
__device__ __forceinline__ void xcd_barrier_complete(unsigned* bar, unsigned x, unsigned& nloc, unsigned& nx) {
    const unsigned G = gridDim.x * gridDim.y * gridDim.z;
    unsigned sum, cnt, mine, sp = 0u;
    for (;;) {
        sum = 0u; cnt = 0u; mine = 0u;
#pragma unroll
        for (unsigned j = 0; j < 16; ++j) { const unsigned c = xb_ld(&bar[XB_XCNT(j)]); sum += c; cnt += (c > 0u) ? 1u : 0u; mine = (j == x) ? c : mine; }
        if (sum == G) break;
        __builtin_amdgcn_s_sleep(1);
        if ((++sp & 255u) == 0u) { if (xb_ld(&bar[XB_TMO])) break; if (sp > XB_SPIN_CAP) { atomicAdd(&bar[XB_TMO], 1u); break; } }
    }
    nloc = mine > 0u ? mine : 1u; nx = cnt > 0u ? cnt : 1u;
}
__device__ __forceinline__ void xcd_barrier(const XcdBarrier& b) {
    asm volatile("s_waitcnt vmcnt(0)" ::: "memory");
    __syncthreads();
    if (threadIdx.x == 0) {
        unsigned* bar = b.bar;
        __builtin_amdgcn_s_waitcnt(0);
        unsigned nloc = b.st[0], nx = b.st[1];
        if (nloc == 0u) { xcd_barrier_complete(bar, b.x, nloc, nx); b.st[0] = nloc; b.st[1] = nx; }
        const unsigned old = xb_add(&bar[XB_XSUB(b.x)], 1u);
        const unsigned gen = old / nloc;
        if (old + 1u == (gen + 1u) * nloc) {
            __builtin_amdgcn_fence(__ATOMIC_RELEASE, "agent");
            asm volatile("s_waitcnt vmcnt(0)" ::: "memory");
            const unsigned og = xb_add(&bar[XB_TOP], 1u);
            const unsigned tg = og / nx;
            if (og + 1u == (tg + 1u) * nx) xb_add(&bar[XB_TOPGEN], 1u);
            else XB_SPIN(xb_ld(&bar[XB_TOPGEN]) == tg, bar);
            __builtin_amdgcn_fence(__ATOMIC_ACQUIRE, "agent");
            xb_add(&bar[XB_XGEN(b.x)], 1u);
            asm volatile("s_waitcnt vmcnt(0)" ::: "memory");
        } else {
            XB_SPIN(xb_ld(&bar[XB_XGEN(b.x)]) == gen, bar);
            __builtin_amdgcn_fence(__ATOMIC_ACQUIRE, "agent");
            asm volatile("s_waitcnt vmcnt(0)" ::: "memory");
        }
    }
    __syncthreads();
}

struct Args { const float* in[22]; float* out; unsigned char* ws; int ph_lo, ph_hi, p5mask, pad; };
struct Frame {
    LAS unsigned char* lds;
    int tid, lane, wave, vcu, G;
};

__device__ __forceinline__ float wave_sum(float v) {
#pragma unroll
    for (int o = 1; o < 64; o <<= 1) v += __shfl_xor(v, o);
    return v;
}
__device__ __forceinline__ unsigned f2bf(float f) { unsigned u = __builtin_bit_cast(unsigned, f); return (u + 0x7fffu + ((u >> 16) & 1u)) >> 16; }
__device__ __forceinline__ unsigned pk2(float lo, float hi) { return f2bf(lo) | (f2bf(hi) << 16); }

__device__ __forceinline__ void p0_transpose_item(const float* W, int K, int N, bf16_t* WT, int drow0, int scol0, int k0, LAS float* scr, int lane) {
#pragma unroll 8
    for (int i = 0; i < 32; ++i) { const int kk = 2 * i + (lane >> 5); scr[kk * 33 + (lane & 31)] = W[(size_t)(k0 + kk) * N + scol0 + (lane & 31)]; }
    LDS_WAIT(); asm volatile("" ::: "memory");
    const int c = lane & 7;
#pragma unroll
    for (int j = 0; j < 4; ++j) { const int n = (lane >> 3) + 8 * j; const LAS float* s = scr + (8 * c) * 33 + n;
        u32x4 o; o.x = pk2(s[0 * 33], s[1 * 33]); o.y = pk2(s[2 * 33], s[3 * 33]); o.z = pk2(s[4 * 33], s[5 * 33]); o.w = pk2(s[6 * 33], s[7 * 33]);
        *(GAS u32x4*)(WT + (size_t)(drow0 + n) * K + k0 + 8 * c) = o; }
    LDS_WAIT(); asm volatile("" ::: "memory");
}
__device__ __forceinline__ int gu_src(int n) { const int p = n >> 8, j = n & 255; return (j < 128) ? 128 * p + j : DFF + 128 * p + (j - 128); }
__device__ __forceinline__ int in_src(int n) {
    if (n < 1536 || n >= 2560) return n;
    const int base = (n < 2048) ? 1536 : 2048, r = n - base, p = r >> 8, j = r & 255, head = 2 * p + ((j >> 6) & 1), half = j >> 7, i = j & 63;
    return base + head * 128 + half * 64 + i;
}
__device__ __forceinline__ const float* xrow_ptr(const Args& a, int m) { return (m < MP) ? a.in[0] + (size_t)m * DM : a.in[1] + (size_t)(m - MP) * DM; }

template <bool HAS_F, bool WRITE_XN>
__device__ __forceinline__ void row_update(const float* base, const bf16_t* f, float coef, const float* gpost, float* out, const float* gpre, bf16_t* xn, int lane, const float* slabrow = nullptr, int nsl = 0) {
    f32x4 v[4];
#pragma unroll
    for (int j = 0; j < 4; ++j) v[j] = ((const GAS f32x4*)base)[lane + 64 * j];
    if constexpr (HAS_F) {
        f32x4 fv[4]; float s = 0.f;
#pragma unroll
        for (int j = 0; j < 4; ++j) {
            if (slabrow != nullptr) { f32x4 a = {0.f, 0.f, 0.f, 0.f}; for (int k = 0; k < nsl; ++k) a += ((const GAS f32x4*)(slabrow + (size_t)k * 256 * 1024))[lane + 64 * j]; fv[j] = a; }
            else { const u32x2 w = ((const GAS u32x2*)f)[lane + 64 * j]; fv[j] = (f32x4){bf_lo(w.x), bf_hi(w.x), bf_lo(w.y), bf_hi(w.y)}; }
            s += (fv[j].x * fv[j].x + fv[j].y * fv[j].y) + (fv[j].z * fv[j].z + fv[j].w * fv[j].w); }
        const float rstd = coef * (1.0f / sqrtf(wave_sum(s) * (1.f / DM) + NORM_EPS));
#pragma unroll
        for (int j = 0; j < 4; ++j) { const f32x4 gp = ((const GAS f32x4*)gpost)[lane + 64 * j]; v[j] = v[j] + fv[j] * rstd * gp; }
#pragma unroll
        for (int j = 0; j < 4; ++j) ((GAS f32x4*)out)[lane + 64 * j] = v[j];
    }
    if constexpr (WRITE_XN) {
        float s2 = 0.f;
#pragma unroll
        for (int j = 0; j < 4; ++j) s2 += (v[j].x * v[j].x + v[j].y * v[j].y) + (v[j].z * v[j].z + v[j].w * v[j].w);
        const float r2 = 1.0f / sqrtf(wave_sum(s2) * (1.f / DM) + NORM_EPS);
#pragma unroll
        for (int j = 0; j < 4; ++j) { const f32x4 gp = ((const GAS f32x4*)gpre)[lane + 64 * j]; const f32x4 o = v[j] * r2 * gp;
            u32x2 w; w.x = cvt_pk_bf16(o.x, o.y); w.y = cvt_pk_bf16(o.z, o.w); ((GAS u32x2*)xn)[lane + 64 * j] = w; }
    }
}

struct EpiGU {
    bf16_t* O;
    __device__ __forceinline__ void operator()(const f32x4 (&acc)[2][2][4][2], const pg8::Unit& u, int wr, int wc, int fr, int fq) const {
        const int row0 = u.pm * 256 + wr * 64 + fr, col0 = u.pn * 128 + wc * 32 + 8 * fq;
#pragma unroll
        for (int ai = 0; ai < 2; ++ai)
#pragma unroll
            for (int m = 0; m < 4; ++m) {
                const f32x4 g0 = acc[ai][0][m][0], g1 = acc[ai][0][m][1], u0 = acc[ai][1][m][0], u1 = acc[ai][1][m][1];
                u32x4 w; w.x = cvt_pk_bf16(siluf_(g0[0]) * u0[0], siluf_(g0[1]) * u0[1]); w.y = cvt_pk_bf16(siluf_(g0[2]) * u0[2], siluf_(g0[3]) * u0[3]);
                w.z = cvt_pk_bf16(siluf_(g1[0]) * u1[0], siluf_(g1[1]) * u1[1]); w.w = cvt_pk_bf16(siluf_(g1[2]) * u1[2], siluf_(g1[3]) * u1[3]);
                *(u32x4*)(O + (size_t)(row0 + ai * 128 + m * 16) * DFF + col0) = w; }
    }
};
struct EpiBf16 {
    bf16_t* O; int ldc; float* slab; int sl;
    __device__ __forceinline__ void operator()(const f32x4 (&acc)[2][2][4][2], const pg8::Unit& u, int wr, int wc, int fr, int fq) const {
        const int row0 = u.pm * 256 + wr * 64 + fr, col0 = u.pn * 256 + wc * 32 + 8 * fq;
        if (slab != nullptr && u.pm == 64) {
            float* sb = slab + (size_t)(u.kt0 / sl) * 256 * 1024 + (size_t)(wr * 64 + fr) * 1024 + col0;
#pragma unroll
            for (int ai = 0; ai < 2; ++ai)
#pragma unroll
                for (int m = 0; m < 4; ++m)
#pragma unroll
                    for (int bj = 0; bj < 2; ++bj) { float* p = sb + (size_t)(ai * 128 + m * 16) * 1024 + bj * 128; *(f32x4*)p = acc[ai][bj][m][0]; *(f32x4*)(p + 4) = acc[ai][bj][m][1]; }
            return; }
#pragma unroll
        for (int ai = 0; ai < 2; ++ai)
#pragma unroll
            for (int m = 0; m < 4; ++m) { bf16_t* rowp = O + (size_t)(row0 + ai * 128 + m * 16) * ldc + col0;
#pragma unroll
                for (int bj = 0; bj < 2; ++bj) { const f32x4 v0 = acc[ai][bj][m][0], v1 = acc[ai][bj][m][1];
                    u32x4 w; w.x = cvt_pk_bf16(v0[0], v0[1]); w.y = cvt_pk_bf16(v0[2], v0[3]); w.z = cvt_pk_bf16(v1[0], v1[1]); w.w = cvt_pk_bf16(v1[2], v1[3]);
                    *(u32x4*)(rowp + bj * 128) = w; } }
    }
};
template <bool ADD> struct EpiGate {
    bf16_t* O; const bf16_t* gate; const bf16_t* T;
    __device__ __forceinline__ void operator()(const f32x4 (&acc)[2][2][4][2], const pg8::Unit& u, int wr, int wc, int fr, int fq) const {
        const int row0 = u.pm * 256 + wr * 64 + fr, col0 = u.pn * 256 + wc * 32 + 8 * fq;
#pragma unroll
        for (int ai = 0; ai < 2; ++ai)
#pragma unroll
            for (int m = 0; m < 4; ++m) { const size_t off = (size_t)(row0 + ai * 128 + m * 16) * DM + col0;
#pragma unroll
                for (int bj = 0; bj < 2; ++bj) { const f32x4 v0 = acc[ai][bj][m][0], v1 = acc[ai][bj][m][1];
                    const u32x4 gw = *(const u32x4*)(gate + off + bj * 128);
                    float o[8] = {v0[0] * bf_lo(gw.x), v0[1] * bf_hi(gw.x), v0[2] * bf_lo(gw.y), v0[3] * bf_hi(gw.y), v1[0] * bf_lo(gw.z), v1[1] * bf_hi(gw.z), v1[2] * bf_lo(gw.w), v1[3] * bf_hi(gw.w)};
                    if constexpr (ADD) { const u32x4 tw = *(const u32x4*)(T + off + bj * 128);
                        o[0] += bf_lo(tw.x); o[1] += bf_hi(tw.x); o[2] += bf_lo(tw.y); o[3] += bf_hi(tw.y); o[4] += bf_lo(tw.z); o[5] += bf_hi(tw.z); o[6] += bf_lo(tw.w); o[7] += bf_hi(tw.w); }
                    u32x4 w; w.x = cvt_pk_bf16(o[0], o[1]); w.y = cvt_pk_bf16(o[2], o[3]); w.z = cvt_pk_bf16(o[4], o[5]); w.w = cvt_pk_bf16(o[6], o[7]);
                    *(u32x4*)(O + off + bj * 128) = w; } }
    }
};
struct EpiIn {
    unsigned char* ws; float* out; const f32x2* tab;
    __device__ __forceinline__ void store8(bf16_t* p, const f32x4& v0, const f32x4& v1, float sc) const {
        u32x4 w; w.x = cvt_pk_bf16(v0[0] * sc, v0[1] * sc); w.y = cvt_pk_bf16(v0[2] * sc, v0[3] * sc); w.z = cvt_pk_bf16(v1[0] * sc, v1[1] * sc); w.w = cvt_pk_bf16(v1[2] * sc, v1[3] * sc);
        *(u32x4*)p = w; }
    __device__ __forceinline__ void operator()(const f32x4 (&acc)[2][2][4][2], const pg8::Unit& u, int wr, int wc, int fr, int fq) const {
        const int row0 = u.pm * 256 + wr * 64 + fr, pn = u.pn, cw = wc * 32 + 8 * fq;
        if (pn < 6) {
            const int which = pn >> 1, colt = (pn & 1) * 256 + cw;
            bf16_t* O = (bf16_t*)(ws + (which == 0 ? WS_QSB : which == 1 ? WS_KSB : WS_VSB));
            const float sc = (which == 0) ? 0.125f * LOG2E : 1.0f;
#pragma unroll
            for (int ai = 0; ai < 2; ++ai)
#pragma unroll
                for (int m = 0; m < 4; ++m) { const int row = row0 + ai * 128 + m * 16;
#pragma unroll
                    for (int bj = 0; bj < 2; ++bj) { store8(O + (size_t)row * SBW + colt + bj * 128, acc[ai][bj][m][0], acc[ai][bj][m][1], sc);
                        if (which != 0) { float* fo = (row < MP) ? out + (which == 1 ? OUT_KP : OUT_VP) + (size_t)row * SBW : out + (which == 1 ? OUT_KS : OUT_VS) + (size_t)(row - MP) * SBW;
                            *(f32x4*)(fo + colt + bj * 128) = acc[ai][bj][m][0]; *(f32x4*)(fo + colt + bj * 128 + 4) = acc[ai][bj][m][1]; } } }
        } else if (pn < 10) {
            const bool isq = pn < 8; const int p = (pn - 6) & 1, head = 2 * p + (wc >> 1), i0 = 32 * (wc & 1) + 8 * fq;
            bf16_t* O = (bf16_t*)(ws + (isq ? WS_QD : WS_KI));
            const float lg = (head == 0) ? -0.04580368961312479f : (head == 1) ? -0.02272007650008353f : (head == 2) ? -0.011315313227834146f : -0.005646563141142063f;
#pragma unroll
            for (int ai = 0; ai < 2; ++ai)
#pragma unroll
                for (int m = 0; m < 4; ++m) { const int row = row0 + ai * 128 + m * 16; const int tpos = (row < MP) ? (row & (SEQ - 1)) : SEQ + ((row - MP) & 7); const int c = tpos & 127;
                    const float sc = isq ? fast_exp2((float)(c + 1) * lg) : 0.08838834764831845f * fast_exp2(-(float)(c + 1) * lg);
                    const f32x4* tp = (const f32x4*)(tab + (size_t)tpos * 64 + i0);
                    const f32x4 t0 = tp[0], t1 = tp[1], t2 = tp[2], t3 = tp[3];
                    const f32x4 a0 = acc[ai][0][m][0], a1 = acc[ai][0][m][1], b0 = acc[ai][1][m][0], b1 = acc[ai][1][m][1];
                    const f32x4 r1a = {a0[0] * t0[0] - b0[0] * t0[1], a0[1] * t0[2] - b0[1] * t0[3], a0[2] * t1[0] - b0[2] * t1[1], a0[3] * t1[2] - b0[3] * t1[3]};
                    const f32x4 r1b = {a1[0] * t2[0] - b1[0] * t2[1], a1[1] * t2[2] - b1[1] * t2[3], a1[2] * t3[0] - b1[2] * t3[1], a1[3] * t3[2] - b1[3] * t3[3]};
                    const f32x4 r2a = {b0[0] * t0[0] + a0[0] * t0[1], b0[1] * t0[2] + a0[1] * t0[3], b0[2] * t1[0] + a0[2] * t1[1], b0[3] * t1[2] + a0[3] * t1[3]};
                    const f32x4 r2b = {b1[0] * t2[0] + a1[0] * t2[1], b1[1] * t2[2] + a1[1] * t2[3], b1[2] * t3[0] + a1[2] * t3[1], b1[3] * t3[2] + a1[3] * t3[3]};
                    bf16_t* rp = O + (size_t)row * RQW + head * 128 + i0;
                    store8(rp, r1a, r1b, sc); store8(rp + 64, r2a, r2b, sc); }
        } else {
            const int which = (pn - 10) >> 2, colt = ((pn - 10) & 3) * 256 + cw;
            bf16_t* O = (bf16_t*)(ws + (which == 0 ? WS_VR : which == 1 ? WS_GR : which == 2 ? WS_GA : WS_GB));
#pragma unroll
            for (int ai = 0; ai < 2; ++ai)
#pragma unroll
                for (int m = 0; m < 4; ++m) { const int row = row0 + ai * 128 + m * 16;
#pragma unroll
                    for (int bj = 0; bj < 2; ++bj) { f32x4 v0 = acc[ai][bj][m][0], v1 = acc[ai][bj][m][1];
                        if (which == 1) { v0 = (f32x4){siluf_(v0[0]), siluf_(v0[1]), siluf_(v0[2]), siluf_(v0[3])}; v1 = (f32x4){siluf_(v1[0]), siluf_(v1[1]), siluf_(v1[2]), siluf_(v1[3])}; }
                        else if (which >= 2) { v0 = (f32x4){sigmoidf_(v0[0]), sigmoidf_(v0[1]), sigmoidf_(v0[2]), sigmoidf_(v0[3])}; v1 = (f32x4){sigmoidf_(v1[0]), sigmoidf_(v1[1]), sigmoidf_(v1[2]), sigmoidf_(v1[3])}; }
                        store8(O + (size_t)row * RVW + colt + bj * 128, v0, v1, 1.0f); } }
        }
    }
};

typedef short v4i16_t __attribute__((ext_vector_type(4)));
#define MFMA32(a, b, c) __builtin_amdgcn_mfma_f32_32x32x16_bf16((a), (b), (c), 0, 0, 0)
__device__ __forceinline__ unsigned imgx(unsigned row) { return ((row & 3u) << 2) | ((row >> 2) & 3u); }
__device__ __forceinline__ unsigned off_b(unsigned row, unsigned ch) { return 256u * row + 16u * (ch ^ imgx(row)); }
__device__ __forceinline__ unsigned row_read_addr(unsigned lane, unsigned row0, unsigned s) { return off_b(row0 + (lane & 31u), 2u * s + (lane >> 5)); }
__device__ __forceinline__ unsigned tr_addr_nat(unsigned lane, unsigned c, unsigned ks, unsigned t) {
    const unsigned h = lane >> 5, blk = (lane >> 4) & 1u, q = (lane & 15u) >> 2, p = lane & 3u;
    return off_b(16u * ks + 8u * h + 4u * t + q, 4u * c + 2u * blk + (p >> 1)) + 8u * (p & 1u); }
__device__ __forceinline__ unsigned tr_addr_acc(unsigned lane, unsigned c, unsigned ks, unsigned t) {
    const unsigned h = lane >> 5, blk = (lane >> 4) & 1u, q = (lane & 15u) >> 2, p = lane & 3u;
    return off_b(16u * ks + 8u * t + 4u * h + q, 4u * c + 2u * blk + (p >> 1)) + 8u * (p & 1u); }
__device__ __forceinline__ s16x4 vtr(const LAS unsigned char* p) { return __builtin_bit_cast(s16x4, __builtin_amdgcn_ds_read_tr16_b64_v4i16((LAS v4i16_t*)p)); }
__device__ __forceinline__ bf16x8 cat8(s16x4 lo, s16x4 hi) { return (bf16x8){lo[0], lo[1], lo[2], lo[3], hi[0], hi[1], hi[2], hi[3]}; }
__device__ __forceinline__ int crow(int r, int hi) { return (r & 3) + 8 * (r >> 2) + 4 * hi; }
__device__ __forceinline__ bf16x8 pack8(const f32x16& x, int s) {
    u32x4 p; p.x = cvt_pk_bf16(x[8 * s], x[8 * s + 1]); p.y = cvt_pk_bf16(x[8 * s + 2], x[8 * s + 3]); p.z = cvt_pk_bf16(x[8 * s + 4], x[8 * s + 5]); p.w = cvt_pk_bf16(x[8 * s + 6], x[8 * s + 7]);
    return __builtin_bit_cast(bf16x8, p); }
__device__ __forceinline__ float ret_lg(int h) { return (h == 0) ? -0.04580368961312479f : (h == 1) ? -0.02272007650008353f : (h == 2) ? -0.011315313227834146f : -0.005646563141142063f; }

template <int ROWS>
__device__ __forceinline__ void ret_stage_dma(LAS unsigned char* stg, const bf16_t* KIt, const bf16_t* VRt, int w, int lane) {
    constexpr int NPK = ROWS / 4, PER = 3 * NPK / 8;
    const unsigned lrow = (unsigned)lane >> 4, lch = (unsigned)lane & 15u;
#pragma unroll
    for (int j = 0; j < PER; ++j) { const int pid = w * PER + j, img = pid / NPK, pc = pid % NPK;
        const unsigned ch = lch ^ ((lrow << 2) | ((unsigned)pc & 3u));
        const char* ub = (img == 0) ? (const char*)(KIt + (size_t)4 * pc * RQW) : (const char*)(VRt + (size_t)4 * pc * RVW + (img - 1) * 128);
        const unsigned voff = (img == 0) ? (lrow * RQW * 2u + ch * 16u) : (lrow * RVW * 2u + ch * 16u);
        __builtin_amdgcn_global_load_lds((const unsigned*)(ub + voff), (LAS unsigned*)(stg + img * (ROWS * 256) + pc * 1024), 16, 0, 0); }
}

__device__ __forceinline__ void ret_scan_unit(const Frame& F, unsigned char* ws, float* out, int bh) {
    const int b = bh >> 2, h = bh & 3, lane = F.lane, w = F.wave, hi = lane >> 5, l31 = lane & 31;
    const bf16_t* KI = (const bf16_t*)(ws + WS_KI) + (size_t)b * SEQ * RQW + h * 128;
    const bf16_t* VR = (const bf16_t*)(ws + WS_VR) + (size_t)b * SEQ * RVW + h * 256;
    bf16_t* SPT = (bf16_t*)(ws + WS_SPT) + (size_t)bh * 32 * 256 * 128;
    LAS unsigned char* ring = F.lds + RING_OFF;
    constexpr int STG = 49152;
    f32x16 S[4];
#pragma unroll
    for (int k = 0; k < 4; ++k)
#pragma unroll
        for (int r = 0; r < 16; ++r) S[k][r] = 0.f;
    const float g128 = fast_exp2(128.0f * ret_lg(h));
    unsigned ka[4][2], va[2];
#pragma unroll
    for (int t = 0; t < 2; ++t) { va[t] = 16384u + (unsigned)(w >> 2) * 16384u + tr_addr_nat(lane, w & 3, 0, t);
#pragma unroll
        for (int kb = 0; kb < 4; ++kb) ka[kb][t] = tr_addr_nat(lane, kb, 0, t); }
    ret_stage_dma<64>(ring, KI, VR, w, lane);
#pragma unroll 1
    for (int i = 0; i < 64; ++i) {
        LAS unsigned char* stg = ring + (i & 1) * STG;
        if (i + 1 < 64) { ret_stage_dma<64>(ring + ((i + 1) & 1) * STG, KI + (size_t)(i + 1) * 64 * RQW, VR + (size_t)(i + 1) * 64 * RVW, w, lane); asm volatile("s_waitcnt vmcnt(6)" ::: "memory"); }
        else asm volatile("s_waitcnt vmcnt(0)" ::: "memory");
        __builtin_amdgcn_s_barrier(); asm volatile("" ::: "memory");
        if ((i & 1) == 0) { bf16_t* sp = SPT + ((size_t)(i >> 1) * 256 + 32 * w + l31) * 128;
#pragma unroll
            for (int kb = 0; kb < 4; ++kb)
#pragma unroll
                for (int g = 0; g < 4; ++g) { u32x2 v; v.x = cvt_pk_bf16(S[kb][4 * g], S[kb][4 * g + 1]); v.y = cvt_pk_bf16(S[kb][4 * g + 2], S[kb][4 * g + 3]);
                    *(u32x2*)(sp + 32 * kb + 8 * g + 4 * hi) = v; } }
#pragma unroll
        for (int ks = 0; ks < 4; ++ks) {
            const bf16x8 bfr = cat8(vtr(stg + va[0] + ks * 4096), vtr(stg + va[1] + ks * 4096));
#pragma unroll
            for (int kb = 0; kb < 4; ++kb) { const bf16x8 afr = cat8(vtr(stg + ka[kb][0] + ks * 4096), vtr(stg + ka[kb][1] + ks * 4096));
                S[kb] = MFMA32(afr, bfr, S[kb]); } }
        if (i & 1) {
#pragma unroll
            for (int kb = 0; kb < 4; ++kb) S[kb] = S[kb] * g128; }
        asm volatile("s_waitcnt lgkmcnt(0)" ::: "memory"); __builtin_amdgcn_s_barrier(); asm volatile("" ::: "memory");
    }
    float* so = out + OUT_SP + (size_t)bh * RDK * RDV + 32 * w + l31;
#pragma unroll
    for (int kb = 0; kb < 4; ++kb)
#pragma unroll
        for (int r = 0; r < 16; ++r) so[(size_t)(32 * kb + crow(r, hi)) * RDV] = S[kb][r];
}

__device__ __forceinline__ void ret_out_unit(const Frame& F, const Args& a, int bh, int n) {
    unsigned char* ws = a.ws;
    const int b = bh >> 2, h = bh & 3, lane = F.lane, w = F.wave, hi = lane >> 5, l31 = lane & 31, cb = w & 3, dvh = w >> 2;
    const size_t row0 = (size_t)b * SEQ + 128 * n;
    LAS unsigned char* ring = F.lds + RING_OFF;
    ret_stage_dma<128>(ring, (const bf16_t*)(ws + WS_KI) + row0 * RQW + h * 128, (const bf16_t*)(ws + WS_VR) + row0 * RVW + h * 256, w, lane);
    const bf16_t* qp = (const bf16_t*)(ws + WS_QD) + (row0 + 32 * cb + l31) * RQW + h * 128 + 8 * hi;
    bf16x8 qf[8];
#pragma unroll
    for (int ks = 0; ks < 8; ++ks) qf[ks] = *(const bf16x8*)(qp + 16 * ks);
    f32x16 o[4];
#pragma unroll
    for (int k = 0; k < 4; ++k)
#pragma unroll
        for (int r = 0; r < 16; ++r) o[k][r] = 0.f;
    const bf16_t* sp = (const bf16_t*)(ws + WS_SPT) + (((size_t)bh * 32 + n) * 256 + dvh * 128 + l31) * 128 + 8 * hi;
#pragma unroll
    for (int dvb = 0; dvb < 4; ++dvb) {
        bf16x8 sf[8];
#pragma unroll
        for (int ks = 0; ks < 8; ++ks) sf[ks] = *(const bf16x8*)(sp + (size_t)dvb * 32 * 128 + 16 * ks);
#pragma unroll
        for (int ks = 0; ks < 8; ++ks) o[dvb] = MFMA32(sf[ks], qf[ks], o[dvb]); }
    asm volatile("s_waitcnt vmcnt(0)" ::: "memory"); __builtin_amdgcn_s_barrier(); asm volatile("" ::: "memory");
    const LAS unsigned char* kimg = ring; const LAS unsigned char* vimg = ring + 32768 + dvh * 32768;
#pragma unroll
    for (int sbk = 0; sbk < 4; ++sbk) {
        if (sbk <= cb) {
            f32x16 X;
#pragma unroll
            for (int r = 0; r < 16; ++r) X[r] = 0.f;
#pragma unroll
            for (int ks = 0; ks < 8; ++ks) { const bf16x8 kf = *(const LAS bf16x8*)(kimg + row_read_addr(lane, 32 * sbk, ks)); X = MFMA32(kf, qf[ks], X); }
            if (sbk == cb) {
#pragma unroll
                for (int r = 0; r < 16; ++r) if (crow(r, hi) > l31) X[r] = 0.f; }
            const bf16x8 pa0 = pack8(X, 0), pa1 = pack8(X, 1);
#pragma unroll
            for (int dvb = 0; dvb < 4; ++dvb) {
                const bf16x8 a0 = cat8(vtr(vimg + tr_addr_acc(lane, dvb, 2 * sbk, 0)), vtr(vimg + tr_addr_acc(lane, dvb, 2 * sbk, 1)));
                const bf16x8 a1 = cat8(vtr(vimg + tr_addr_acc(lane, dvb, 2 * sbk + 1, 0)), vtr(vimg + tr_addr_acc(lane, dvb, 2 * sbk + 1, 1)));
                o[dvb] = MFMA32(a0, pa0, o[dvb]); o[dvb] = MFMA32(a1, pa1, o[dvb]); }
        }
    }
    float ssq = 0.f;
#pragma unroll
    for (int dvb = 0; dvb < 4; ++dvb)
#pragma unroll
        for (int r = 0; r < 16; ++r) ssq += o[dvb][r] * o[dvb][r];
    ssq += __shfl_xor(ssq, 32);
    LAS float* red = (LAS float*)(ring + 98304);
    if (hi == 0) red[w * 32 + l31] = ssq;
    asm volatile("s_waitcnt lgkmcnt(0)" ::: "memory"); __builtin_amdgcn_s_barrier(); asm volatile("" ::: "memory");
    const float tot = red[w * 32 + l31] + red[(w ^ 4) * 32 + l31];
    const float rstd = 1.0f / sqrtf(tot * (1.0f / RDV) + NORM_EPS);
    const size_t row = row0 + 32 * cb + l31;
    const bf16_t* gr = (const bf16_t*)(ws + WS_GR) + row * RVW + h * 256 + dvh * 128 + 4 * hi;
    bf16_t* orp = (bf16_t*)(ws + WS_OR) + row * RVW + h * 256 + dvh * 128 + 4 * hi;
    const float* gn = a.in[13] + h * 256 + dvh * 128 + 4 * hi;
#pragma unroll
    for (int dvb = 0; dvb < 4; ++dvb)
#pragma unroll
        for (int g = 0; g < 4; ++g) { const int d = 32 * dvb + 8 * g; const u32x2 gw = *(const u32x2*)(gr + d); const f32x4 gv = *(const f32x4*)(gn + d);
            u32x2 v; v.x = cvt_pk_bf16(o[dvb][4 * g] * rstd * gv[0] * bf_lo(gw.x), o[dvb][4 * g + 1] * rstd * gv[1] * bf_hi(gw.x));
            v.y = cvt_pk_bf16(o[dvb][4 * g + 2] * rstd * gv[2] * bf_lo(gw.y), o[dvb][4 * g + 3] * rstd * gv[3] * bf_hi(gw.y));
            *(u32x2*)(orp + d) = v; }
    asm volatile("s_waitcnt lgkmcnt(0)" ::: "memory"); __builtin_amdgcn_s_barrier(); asm volatile("" ::: "memory");
}

__device__ __forceinline__ void ret_sample_unit(const Frame& F, const Args& a, int sq, int h) {
    unsigned char* ws = a.ws;
    const int lane = F.lane, w = F.wave, tid = F.tid, dvq = w & 3, dkh = w >> 2, dv = 64 * dvq + lane;
    const size_t row0 = (size_t)MP + sq * 8;
    LAS float* QDt = (LAS float*)(F.lds + RING_OFF); LAS float* KIt = QDt + 1024; LAS float* inner = KIt + 1024; LAS float* red = inner + 64; LAS float* ssb = red + 2 * 8 * 256;
    const bf16_t* QD = (const bf16_t*)(ws + WS_QD) + row0 * RQW + h * 128; const bf16_t* KI = (const bf16_t*)(ws + WS_KI) + row0 * RQW + h * 128;
#pragma unroll
    for (int e = tid; e < 1024; e += 512) { const int c = e >> 7, dk = e & 127; QDt[dk * 8 + c] = __uint_as_float((unsigned)QD[(size_t)c * RQW + dk] << 16); KIt[dk * 8 + c] = __uint_as_float((unsigned)KI[(size_t)c * RQW + dk] << 16); }
    __syncthreads();
    if (w == 0) { const int c = lane >> 3, s = lane & 7; float acc = 0.f; for (int dk = 0; dk < 128; ++dk) acc += QDt[dk * 8 + c] * KIt[dk * 8 + s]; inner[lane] = acc; }
    const bf16_t* VR = (const bf16_t*)(ws + WS_VR) + row0 * RVW + h * 256 + dv;
    float v[8], acc[8];
#pragma unroll
    for (int s = 0; s < 8; ++s) { v[s] = __uint_as_float((unsigned)VR[(size_t)s * RVW] << 16); acc[s] = 0.f; }
    const float g8 = fast_exp2(8.0f * ret_lg(h));
    const float* Sin = a.in[4] + (size_t)(sq * 4 + h) * RDK * RDV + dv; float* Sout = a.out + OUT_SS + (size_t)(sq * 4 + h) * RDK * RDV + dv;
#pragma unroll 4
    for (int dk = 64 * dkh; dk < 64 * dkh + 64; ++dk) {
        const float Sv = Sin[(size_t)dk * RDV];
        const f32x4 q0 = *(const LAS f32x4*)(QDt + dk * 8), q1 = *(const LAS f32x4*)(QDt + dk * 8 + 4), k0 = *(const LAS f32x4*)(KIt + dk * 8), k1 = *(const LAS f32x4*)(KIt + dk * 8 + 4);
        acc[0] += q0[0] * Sv; acc[1] += q0[1] * Sv; acc[2] += q0[2] * Sv; acc[3] += q0[3] * Sv; acc[4] += q1[0] * Sv; acc[5] += q1[1] * Sv; acc[6] += q1[2] * Sv; acc[7] += q1[3] * Sv;
        const float kv = (k0[0] * v[0] + k0[1] * v[1]) + (k0[2] * v[2] + k0[3] * v[3]) + (k1[0] * v[4] + k1[1] * v[5]) + (k1[2] * v[6] + k1[3] * v[7]);
        Sout[(size_t)dk * RDV] = g8 * (Sv + kv);
    }
#pragma unroll
    for (int c = 0; c < 8; ++c) red[(dkh * 8 + c) * 256 + dv] = acc[c];
    __syncthreads();
    float o[8];
    if (dkh == 0) {
#pragma unroll
        for (int c = 0; c < 8; ++c) { float x = red[c * 256 + dv] + red[(8 + c) * 256 + dv];
#pragma unroll
            for (int s = 0; s < 8; ++s) if (s <= c) x += inner[c * 8 + s] * v[s];
            o[c] = x; const float q = wave_sum(x * x); if (lane == 0) ssb[dvq * 8 + c] = q; }
    }
    __syncthreads();
    if (dkh == 0) {
        const float gnv = a.in[13][h * 256 + dv];
        const bf16_t* GR = (const bf16_t*)(ws + WS_GR) + row0 * RVW + h * 256 + dv; bf16_t* OR = (bf16_t*)(ws + WS_OR) + row0 * RVW + h * 256 + dv;
#pragma unroll
        for (int c = 0; c < 8; ++c) { const float tot = (ssb[c] + ssb[8 + c]) + (ssb[16 + c] + ssb[24 + c]); const float rstd = 1.0f / sqrtf(tot * (1.0f / RDV) + NORM_EPS);
            OR[(size_t)c * RVW] = (bf16_t)f2bf(o[c] * rstd * gnv * __uint_as_float((unsigned)GR[(size_t)c * RVW] << 16)); }
    }
    __syncthreads();
}

template <bool ADD = false>
__device__ __forceinline__ void sb_scan(f32x16& p, float& R, int hi, float badd = 0.f) {
    float t[16], w[16];
#pragma unroll
    for (int r = 0; r < 16; ++r) { t[r] = fast_exp2(ADD ? p[r] + badd : p[r]); w[r] = fast_rcp(1.0f + t[r]); }
    float G0[4], G1[4];
#pragma unroll
    for (int g = 0; g < 4; ++g) { const float G = (w[4 * g] * w[4 * g + 1]) * (w[4 * g + 2] * w[4 * g + 3]);
        auto rr = __builtin_amdgcn_permlane32_swap(__float_as_uint(G), __float_as_uint(G), false, false); G0[g] = __uint_as_float(rr[0]); G1[g] = __uint_as_float(rr[1]); }
    const float T0 = G0[0] * G1[0], T1 = G0[1] * G1[1], T2 = G0[2] * G1[2], T3 = G0[3] * G1[3];
    const float U2 = T3, U1 = T3 * T2, U0 = U1 * T1;
    float L[4];
    L[3] = R * (hi ? 1.0f : G1[3]); L[2] = R * U2 * (hi ? 1.0f : G1[2]); L[1] = R * U1 * (hi ? 1.0f : G1[1]); L[0] = R * U0 * (hi ? 1.0f : G1[0]);
#pragma unroll
    for (int g = 0; g < 4; ++g) { float incl = L[g];
#pragma unroll
        for (int i = 3; i >= 0; --i) { incl *= w[4 * g + i]; p[4 * g + i] = t[4 * g + i] * incl; } }
    R = R * U0 * T0;
}
__device__ __forceinline__ void sb_qk(const LAS unsigned char* kslot, const bf16x8 (&qr)[4], const f32x16& binit, float& R, bool mask, int dmask, int lane, bf16x8 (&pa)[4]) {
    const int hi = lane >> 5, r32 = lane & 31;
    const LAS unsigned char* kp = kslot + hi * 1024 + r32 * 16;
    f32x16 p0 = binit, p1 = binit;
#pragma unroll
    for (int d0 = 0; d0 < 4; ++d0) { const bf16x8 k0 = *(const LAS bf16x8*)(kp + d0 * 2048), k1 = *(const LAS bf16x8*)(kp + d0 * 2048 + 512);
        p0 = MFMA32(k0, qr[d0], p0); p1 = MFMA32(k1, qr[d0], p1); }
    if (mask) {
#pragma unroll
        for (int r = 0; r < 16; ++r) { const int kv = dmask + (r & 3) + 8 * (r >> 2); if (kv >= 0) p0[r] = -INFINITY; if (kv + 32 >= 0) p1[r] = -INFINITY; } }
    sb_scan(p1, R, hi); sb_scan(p0, R, hi);
    pa[0] = pack8(p0, 0); pa[1] = pack8(p0, 1); pa[2] = pack8(p1, 0); pa[3] = pack8(p1, 1);
}
__device__ __forceinline__ void sb_pv(const LAS unsigned char* vslot, const bf16x8 (&pa)[4], f32x16 (&o)[2], int lane) {
    const int hi = lane >> 5;
    const LAS unsigned char* vp = vslot + ((lane >> 4) & 1) * 32 + (lane & 3) * 8 + (4 * hi + ((lane & 15) >> 2)) * 64;
#pragma unroll
    for (int d0 = 0; d0 < 2; ++d0) {
        const bf16x8 v0 = cat8(vtr(vp + d0 * 4096), vtr(vp + d0 * 4096 + 512)), v1 = cat8(vtr(vp + d0 * 4096 + 1024), vtr(vp + d0 * 4096 + 1024 + 512));
        const bf16x8 v2 = cat8(vtr(vp + d0 * 4096 + 2048), vtr(vp + d0 * 4096 + 2048 + 512)), v3 = cat8(vtr(vp + d0 * 4096 + 3072), vtr(vp + d0 * 4096 + 3072 + 512));
        o[d0] = MFMA32(pa[0], v0, o[d0]); o[d0] = MFMA32(pa[1], v1, o[d0]); o[d0] = MFMA32(pa[2], v2, o[d0]); o[d0] = MFMA32(pa[3], v3, o[d0]); }
}
__device__ __forceinline__ void sb_tile(const LAS unsigned char* kslot, const LAS unsigned char* vslot, const bf16x8 (&qr)[4], const f32x16& binit, float& R, f32x16 (&o)[2], bool mask, int dmask, int lane) {
    bf16x8 pa[4]; sb_qk(kslot, qr, binit, R, mask, dmask, lane, pa); sb_pv(vslot, pa, o, lane);
}
constexpr int AT_SLOT = 8192, AT_K = 0, AT_V = 3 * AT_SLOT, AT_OST = 6 * AT_SLOT;
__device__ __forceinline__ void sb_unit(const Frame& F, unsigned char* ws, const float* sb_bias, int b, int h, int qb) {
    const int lane = F.lane, r32 = lane & 31, hi = lane >> 5, wid = F.wave;
    const size_t rowbase = (size_t)b * SEQ; const int q0 = qb * 256;
    LAS unsigned char* ring = F.lds + RING_OFF;
    const bf16_t* Qw = (const bf16_t*)(ws + WS_QSB) + (rowbase + q0 + wid * 32) * SBW + h * 64;
    const bf16_t* ksrc = (const bf16_t*)(ws + WS_KSB) + rowbase * SBW + h * 64 + (size_t)lane * SBW + wid * 8;
    const bf16_t* vsrc = (const bf16_t*)(ws + WS_VSB) + rowbase * SBW + h * 64 + (size_t)(16 * (wid & 3) + (lane >> 2)) * SBW + (wid >> 2) * 32 + (lane & 3) * 8;
    bf16x8 qr[4];
#pragma unroll
    for (int d0 = 0; d0 < 4; ++d0) qr[d0] = *(const bf16x8*)(Qw + (size_t)r32 * SBW + d0 * 16 + hi * 8);
    const float bias2 = sb_bias[h] * LOG2E;
    f32x16 binit;
#pragma unroll
    for (int r = 0; r < 16; ++r) binit[r] = bias2;
    asm volatile("" : "+v"(binit));
    f32x16 o[2];
#pragma unroll
    for (int r = 0; r < 16; ++r) { o[0][r] = 0.f; o[1][r] = 0.f; }
    float R = 1.0f;
    const int NT = (q0 + 256) / 64;
#define SB_DMA(t, slot) do { __builtin_amdgcn_global_load_lds((const unsigned*)(ksrc + (size_t)(t) * 64 * SBW), (LAS unsigned*)(ring + AT_K + (slot) * AT_SLOT + wid * 1024), 16, 0, 0); \
                             __builtin_amdgcn_global_load_lds((const unsigned*)(vsrc + (size_t)(t) * 64 * SBW), (LAS unsigned*)(ring + AT_V + (slot) * AT_SLOT + wid * 1024), 16, 0, 0); } while (0)
    SB_DMA(NT - 1, 0); SB_DMA(NT - 2, 1);
    int slot = 0;
#pragma unroll 1
    for (int it = 0; it < NT; ++it) {
        const int t = NT - 1 - it;
        if (it + 1 < NT) asm volatile("s_waitcnt vmcnt(2)" ::: "memory"); else asm volatile("s_waitcnt vmcnt(0)" ::: "memory");
        __builtin_amdgcn_s_barrier(); asm volatile("" ::: "memory");
        if (it + 2 < NT) { const int s2 = (slot == 0) ? 2 : slot - 1; SB_DMA(t - 2, s2); }
        const int qmin = q0 + 32 * wid;
        if (64 * t <= qmin + 30) sb_tile(ring + AT_K + slot * AT_SLOT, ring + AT_V + slot * AT_SLOT, qr, binit, R, o, 64 * t + 63 >= qmin, 64 * t + 4 * hi - (qmin + r32), lane);
        asm volatile("s_waitcnt lgkmcnt(0)" ::: "memory");
        slot = (slot == 2) ? 0 : slot + 1;
    }
#undef SB_DMA
    bf16_t* Ow = (bf16_t*)(ws + WS_OSB) + (rowbase + q0 + wid * 32) * SBW + h * 64;
    LAS bf16_t* stg = (LAS bf16_t*)(ring + AT_OST) + wid * 2048;
#pragma unroll
    for (int r = 0; r < 16; ++r) { const int orow = crow(r, hi);
#pragma unroll
        for (int d0 = 0; d0 < 2; ++d0) stg[orow * 64 + d0 * 32 + r32] = (bf16_t)f2bf(o[d0][r]); }
    asm volatile("s_waitcnt lgkmcnt(0)" ::: "memory");
#pragma unroll
    for (int i = 0; i < 4; ++i) { const int row = i * 8 + (lane >> 3), ch = lane & 7; const u32x4 v = *(const LAS u32x4*)(stg + row * 64 + ch * 8); *(u32x4*)(Ow + (size_t)row * SBW + ch * 8) = v; }
    asm volatile("s_waitcnt lgkmcnt(0)" ::: "memory"); __builtin_amdgcn_s_barrier(); asm volatile("" ::: "memory");
}
__device__ __forceinline__ void sbdec_step(const LAS unsigned char* kslot, const bf16x8 (&qr)[4], float bias2, float& R, bool mask, int dmask, int lane, bf16x8 (&pa)[2]) {
    const int hi = lane >> 5, r32 = lane & 31;
    const LAS unsigned char* kp = kslot + hi * 1024 + r32 * 16;
    f32x16 p;
#pragma unroll
    for (int r = 0; r < 16; ++r) p[r] = 0.f;
#pragma unroll
    for (int d0 = 0; d0 < 4; ++d0) { const bf16x8 k0 = *(const LAS bf16x8*)(kp + d0 * 2048); p = MFMA32(k0, qr[d0], p); }
    if (mask) {
#pragma unroll
        for (int r = 0; r < 16; ++r) { const int kv = dmask + (r & 3) + 8 * (r >> 2); if (kv >= 0) p[r] = -INFINITY; } }
    sb_scan<true>(p, R, hi, bias2);
    pa[0] = pack8(p, 0); pa[1] = pack8(p, 1);
}
__device__ __forceinline__ void sbdec_pv(const LAS unsigned char* vslot, const bf16x8 (&pa)[2], f32x16 (&o)[2], int lane) {
    const int hi = lane >> 5;
    const LAS unsigned char* vp = vslot + ((lane >> 4) & 1) * 32 + (lane & 3) * 8 + (4 * hi + ((lane & 15) >> 2)) * 64;
#pragma unroll
    for (int d0 = 0; d0 < 2; ++d0) {
        const bf16x8 v0 = cat8(vtr(vp + d0 * 4096), vtr(vp + d0 * 4096 + 512)), v1 = cat8(vtr(vp + d0 * 4096 + 1024), vtr(vp + d0 * 4096 + 1024 + 512));
        o[d0] = MFMA32(pa[0], v0, o[d0]); o[d0] = MFMA32(pa[1], v1, o[d0]); }
}
__device__ __forceinline__ void sbdec_unit(const Frame& F, const Args& a, int sq, int c) {
    unsigned char* ws = a.ws;
    const int lane = F.lane, r32 = lane & 31, hi = lane >> 5, h = F.wave;
    LAS unsigned char* kslot = F.lds + RING_OFF + h * 16384; LAS unsigned char* vslot = kslot + 8192;
    const size_t qrow = (size_t)MP + sq * 8;
    bf16x8 qr[4];
#pragma unroll
    for (int d0 = 0; d0 < 4; ++d0) { bf16x8 v = {0, 0, 0, 0, 0, 0, 0, 0}; if (r32 < 8) v = *(const bf16x8*)((const bf16_t*)(ws + WS_QSB) + (qrow + r32) * SBW + h * 64 + d0 * 16 + hi * 8); qr[d0] = v; }
    const float bias2 = a.in[12][h] * LOG2E;
    f32x16 o[2];
#pragma unroll
    for (int r = 0; r < 16; ++r) { o[0][r] = 0.f; o[1][r] = 0.f; }
    float R = 1.0f;
    bf16x8 pa[2];
    if (c == 15) {
        const bf16_t* kn = (const bf16_t*)(ws + WS_KSB) + (qrow + (lane & 7)) * SBW + h * 64; const bf16_t* vn = (const bf16_t*)(ws + WS_VSB) + (qrow + (lane & 7)) * SBW + h * 64;
#pragma unroll
        for (int ch = 0; ch < 8; ++ch) { u32x4 kv = {0u, 0u, 0u, 0u}, vv = {0u, 0u, 0u, 0u}; if (lane < 8) { kv = *(const u32x4*)(kn + ch * 8); vv = *(const u32x4*)(vn + ch * 8); }
            if (lane < 32) { *(LAS u32x4*)(kslot + ch * 1024 + lane * 16) = kv; *(LAS u32x4*)(vslot + (ch >> 2) * 4096 + lane * 64 + (ch & 3) * 16) = vv; } }
        asm volatile("s_waitcnt lgkmcnt(0)" ::: "memory");
        sbdec_step(kslot, qr, bias2, R, true, 4 * hi - r32, lane, pa); sbdec_pv(vslot, pa, o, lane);
        asm volatile("s_waitcnt lgkmcnt(0)" ::: "memory");
    }
    const int* ptab = (const int*)a.in[5] + sq * NPAGES + c * 4;
    const int lrow = lane >> 4, lc = lane & 15;
    const size_t lane_e = ((size_t)lrow * SBH + h) * SBD + lc * 4;
    f32x4 kr[8], vr[8];
#define DEC_LOAD(dst, base, tt_) do { const int page_ = __builtin_amdgcn_readfirstlane(ptab[(tt_) >> 2]); const float* g_ = (base) + ((size_t)page_ * PAGE + ((tt_) & 3) * 32) * SBH * SBD + lane_e; \
        _Pragma("unroll") for (int i = 0; i < 8; ++i) dst[i] = __builtin_nontemporal_load((const f32x4*)(g_ + (size_t)i * 4 * SBH * SBD)); } while (0)
    DEC_LOAD(kr, a.in[2], 15); DEC_LOAD(vr, a.in[3], 15);
#pragma unroll 1
    for (int tt = 15; tt >= 0; --tt) {
#pragma unroll
        for (int i = 0; i < 8; ++i) { const int row = 4 * i + lrow; u32x2 w; w.x = cvt_pk_bf16(kr[i][0], kr[i][1]); w.y = cvt_pk_bf16(kr[i][2], kr[i][3]);
            *(LAS u32x2*)(kslot + (lc >> 1) * 1024 + row * 16 + (lc & 1) * 8) = w; }
        if (tt > 0) DEC_LOAD(kr, a.in[2], tt - 1);
        asm volatile("s_waitcnt lgkmcnt(0)" ::: "memory");
        sbdec_step(kslot, qr, bias2, R, false, 0, lane, pa);
#pragma unroll
        for (int i = 0; i < 8; ++i) { const int row = 4 * i + lrow; u32x2 w; w.x = cvt_pk_bf16(vr[i][0], vr[i][1]); w.y = cvt_pk_bf16(vr[i][2], vr[i][3]);
            *(LAS u32x2*)(vslot + (lc >> 3) * 4096 + row * 64 + (lc & 7) * 8) = w; }
        if (tt > 0) DEC_LOAD(vr, a.in[3], tt - 1);
        asm volatile("s_waitcnt lgkmcnt(0)" ::: "memory");
        sbdec_pv(vslot, pa, o, lane);
        asm volatile("s_waitcnt lgkmcnt(0)" ::: "memory");
    }
#undef DEC_LOAD
    float* part = (float*)(ws + WS_DPART) + ((size_t)((sq * 16 + c) * 8 + h) * 8) * 64;
#pragma unroll
    for (int r = 0; r < 4; ++r)
#pragma unroll
        for (int d0 = 0; d0 < 2; ++d0) part[(size_t)(r + 4 * hi) * 64 + 32 * d0 + r32] = o[d0][r];
    float* pr = (float*)(ws + WS_DPART + 16 * MiB) + (size_t)((sq * 16 + c) * 8 + h) * 8;
    if (lane < 8) pr[lane] = R;
    __syncthreads();
}
__device__ __forceinline__ void sbdec_combine(unsigned char* ws, size_t e) {
    const int d = (int)(e & 63), q = (int)((e >> 6) & 7), h = (int)((e >> 9) & 7), sq = (int)(e >> 12);
    const float* part = (const float*)(ws + WS_DPART); const float* pr = (const float*)(ws + WS_DPART + 16 * MiB);
    float acc = 0.f, f = 1.0f;
#pragma unroll
    for (int c = 15; c >= 0; --c) { const size_t u = (size_t)((sq * 16 + c) * 8 + h) * 8 + q; acc += f * part[u * 64 + d]; f *= pr[u]; }
    ((bf16_t*)(ws + WS_OSB))[((size_t)MP + sq * 8 + q) * SBW + h * 64 + d] = (bf16_t)f2bf(acc);
}

__device__ __forceinline__ void p0_prologue(const Frame& F, const Args& a) {
    LAS float* scr = (LAS float*)(F.lds + RING_OFF + F.wave * 16384);
    const int gw = F.vcu * NWAVES + F.wave, NGW = F.G * NWAVES;
    unsigned char* ws = a.ws;
    constexpr int I_GU = (DM / 64) * (2 * DFF / 32), I_DN = (DFF / 64) * (DM / 32), I_IN = (DM / 64) * (INW / 32), I_SBO = (SBW / 64) * (DM / 32), I_RO = (RVW / 64) * (DM / 32), I_O = (DM / 64) * (DM / 32);
    constexpr int NITEMS = 2 * I_GU + 2 * I_DN + I_IN + I_SBO + I_RO + I_O;
    for (int it = gw; it < NITEMS; it += NGW) {
        int r = it;
        if (r < 2 * I_GU) { const int l = r / I_GU; r -= l * I_GU; const int nb = r % (2 * DFF / 32), kb = r / (2 * DFF / 32);
            p0_transpose_item(a.in[l ? 19 : 7], DM, 2 * DFF, (bf16_t*)(ws + (l ? WS_WGU2 : WS_WGU1)), 32 * nb, gu_src(32 * nb), 64 * kb, scr, F.lane); continue; } r -= 2 * I_GU;
        if (r < 2 * I_DN) { const int l = r / I_DN; r -= l * I_DN; const int nb = r % (DM / 32), kb = r / (DM / 32);
            p0_transpose_item(a.in[l ? 20 : 8], DFF, DM, (bf16_t*)(ws + (l ? WS_WDN2 : WS_WDN1)), 32 * nb, 32 * nb, 64 * kb, scr, F.lane); continue; } r -= 2 * I_DN;
        if (r < I_IN) { const int nb = r % (INW / 32), kb = r / (INW / 32);
            p0_transpose_item(a.in[11], DM, INW, (bf16_t*)(ws + WS_WIN), 32 * nb, in_src(32 * nb), 64 * kb, scr, F.lane); continue; } r -= I_IN;
        if (r < I_SBO) { const int nb = r % (DM / 32), kb = r / (DM / 32);
            p0_transpose_item(a.in[14], SBW, DM, (bf16_t*)(ws + WS_WSBO), 32 * nb, 32 * nb, 64 * kb, scr, F.lane); continue; } r -= I_SBO;
        if (r < I_RO) { const int nb = r % (DM / 32), kb = r / (DM / 32);
            p0_transpose_item(a.in[15], RVW, DM, (bf16_t*)(ws + WS_WRO), 32 * nb, 32 * nb, 64 * kb, scr, F.lane); continue; } r -= I_RO;
        { const int nb = r % (DM / 32), kb = r / (DM / 32);
            p0_transpose_item(a.in[16], DM, DM, (bf16_t*)(ws + WS_WO), 32 * nb, 32 * nb, 64 * kb, scr, F.lane); }
    }
    { f32x2* tab = (f32x2*)(ws + WS_TAB);
      for (int e = gw * 64 + F.lane; e < (SEQ + DECS) * 64; e += NGW * 64) { const int tp = e >> 6, i = e & 63; const int pos = (tp < SEQ) ? tp : PAST + (tp - SEQ);
          const float freq = (float)exp2(-(double)i * (13.287712379549449 / 64.0)); const float ang = (float)pos * freq;
          double x = (double)ang * 0.15915494309189535; x -= floor(x); const float xf = (float)x;
          tab[e] = (f32x2){__builtin_amdgcn_cosf(xf), __builtin_amdgcn_sinf(xf)}; } }
    for (int m = gw; m < MT; m += NGW) row_update<false, true>(xrow_ptr(a, m), nullptr, 0.f, nullptr, nullptr, a.in[6], (bf16_t*)(ws + WS_XN) + (size_t)m * DM, F.lane);
}

__global__ void __launch_bounds__(NWAVES * 64, 2) mega_fwd(Args args) {
    extern __shared__ __attribute__((aligned(16))) unsigned char lds[];
    Frame F;
    F.lds = (LAS unsigned char*)lds;
    volatile LAS unsigned* MISC = (volatile LAS unsigned*)(F.lds + MISC_OFF);
    F.tid = threadIdx.x; F.lane = F.tid & 63; F.wave = __builtin_amdgcn_readfirstlane(F.tid >> 6);
    F.G = gridDim.x; { const int bx = blockIdx.x; F.vcu = (F.G % 8 == 0) ? (bx % 8) * (F.G / 8) + bx / 8 : bx; }
    unsigned char* ws = args.ws;
    unsigned* ctl = (unsigned*)(ws + WS_CTL);
    for (int u = F.tid; u < (LDS_BYTES - LDSCTL_OFF) / 4; u += NWAVES * 64) ((LAS unsigned*)(F.lds + LDSCTL_OFF))[u] = 0u;
    __syncthreads();
    const int lo = args.ph_lo, hi = args.ph_hi;
    const bool multi = (hi - lo) > 1;
    XcdBarrier bar; bar.bar = ctl + CW_BAR; bar.x = 0; bar.st = nullptr;
    if (multi) bar = xcd_barrier_post(ctl + CW_BAR, MISC + 8);
#define IN(k) (lo <= (k) && (k) < hi)
#define SEAM(k) do { if (IN(k) && IN((k) + 1)) xcd_barrier(bar); } while (0)
    LAS unsigned char* ring = F.lds + RING_OFF;
    const int bx = (int)blockIdx.x;

    if (IN(0)) { p0_prologue(F, args); } SEAM(0);
    if (IN(1)) { pg8::Gemm g{(const bf16_t*)(ws + WS_XN), (const bf16_t*)(ws + WS_WGU1), DM}; pg8::TileOrder S; S.init(MT / 256, 2 * DFF / 256, DM / 64, F.G, bx);
        EpiGU E{(bf16_t*)(ws + WS_ACT)}; pg8::gemm_phase<EpiGU, pg8::TileOrder, true, true>(ring, g, S, E); } SEAM(1);
    if (IN(2)) { pg8::Gemm g{(const bf16_t*)(ws + WS_ACT), (const bf16_t*)(ws + WS_WDN1), DFF}; pg8::PanelOrder S; S.init(DFF / 64, 4, F.G, bx);
        EpiBf16 E{(bf16_t*)(ws + WS_F), DM, (float*)(ws + WS_SLAB), 4}; pg8::gemm_phase<EpiBf16, pg8::PanelOrder, true, true>(ring, g, S, E); } SEAM(2);
    if (IN(3)) { const int gw = F.vcu * NWAVES + F.wave, NGW = F.G * NWAVES;
        for (int m = gw; m < MT; m += NGW) row_update<true, true>(xrow_ptr(args, m), (const bf16_t*)(ws + WS_F) + (size_t)m * DM, 0.5f, args.in[9], (float*)(ws + WS_H) + (size_t)m * DM, args.in[10], (bf16_t*)(ws + WS_XN) + (size_t)m * DM, F.lane, (m >= MP) ? (const float*)(ws + WS_SLAB) + (size_t)(m - MP) * DM : nullptr, DFF / 256); } SEAM(3);
    if (IN(4)) { pg8::Gemm g{(const bf16_t*)(ws + WS_XN), (const bf16_t*)(ws + WS_WIN), DM}; pg8::TileOrder S; S.init(MT / 256, INW / 256, DM / 64, F.G, bx);
        EpiIn E{ws, args.out, (const f32x2*)(ws + WS_TAB)}; pg8::gemm_phase<EpiIn, pg8::TileOrder, true, true>(ring, g, S, E); } SEAM(4);
    if (IN(5)) {
#define GRAB(qi) ({ if (F.tid == 0) MISC[0] = __hip_atomic_fetch_add(ctl + CW_Q + 64 * (qi), 1u, __ATOMIC_RELAXED, __HIP_MEMORY_SCOPE_AGENT); __syncthreads(); \
                    const int u_ = __builtin_amdgcn_readfirstlane((int)MISC[0]); __syncthreads(); u_; })
        const bool roleD = ((bx >> 3) & 15) < 7;
        const int pm5 = args.p5mask;
        if (pm5 & 1) for (;;) { const int u = GRAB(0); if (u >= 16) break; ret_scan_unit(F, ws, args.out, u); }
        if (roleD && (pm5 & 2)) for (;;) { const int u = GRAB(1); if (u >= 512) break; sbdec_unit(F, args, u >> 4, u & 15); }
        if (pm5 & 4) for (;;) { const int u = GRAB(2); if (u >= 512) break; sb_unit(F, ws, args.in[12], (u & 31) >> 3, u & 7, 15 - (u >> 5)); }
        if (!roleD && (pm5 & 2)) for (;;) { const int u = GRAB(1); if (u >= 512) break; sbdec_unit(F, args, u >> 4, u & 15); }
        if (pm5 & 8) for (;;) { const int u = GRAB(3); if (u >= DECB * RH) break; ret_sample_unit(F, args, u >> 2, u & 3); }
#undef GRAB
    } SEAM(5);
    if (IN(6)) { for (int u = F.vcu; u < 512; u += F.G) ret_out_unit(F, args, u >> 5, u & 31);
        for (size_t e = (size_t)bx * 512 + F.tid; e < (size_t)DECB * 8 * 8 * 64; e += (size_t)F.G * 512) sbdec_combine(ws, e); } SEAM(6);
    if (IN(7)) { pg8::Gemm g{(const bf16_t*)(ws + WS_OSB), (const bf16_t*)(ws + WS_WSBO), SBW}; pg8::TileOrder S; S.init(MT / 256, DM / 256, SBW / 64, F.G, bx);
        EpiGate<false> E{(bf16_t*)(ws + WS_T1), (const bf16_t*)(ws + WS_GA), nullptr}; pg8::gemm_phase<EpiGate<false>, pg8::TileOrder, true, true>(ring, g, S, E); }
    if (IN(7)) { pg8::Gemm g{(const bf16_t*)(ws + WS_OR), (const bf16_t*)(ws + WS_WRO), RVW}; pg8::TileOrder S; S.init(MT / 256, DM / 256, RVW / 64, F.G, bx);
        EpiGate<true> E{(bf16_t*)(ws + WS_MB), (const bf16_t*)(ws + WS_GB), (const bf16_t*)(ws + WS_T1)}; pg8::gemm_phase<EpiGate<true>, pg8::TileOrder, true, true>(ring, g, S, E); } SEAM(7);
    if (IN(8)) { pg8::Gemm g{(const bf16_t*)(ws + WS_MB), (const bf16_t*)(ws + WS_WO), DM}; pg8::PanelOrder S; S.init(DM / 64, 4, F.G, bx);
        EpiBf16 E{(bf16_t*)(ws + WS_F), DM, (float*)(ws + WS_SLAB), 4}; pg8::gemm_phase<EpiBf16, pg8::PanelOrder, true, true>(ring, g, S, E); } SEAM(8);
    if (IN(9)) { const int gw = F.vcu * NWAVES + F.wave, NGW = F.G * NWAVES;
        for (int m = gw; m < MT; m += NGW) row_update<true, true>((const float*)(ws + WS_H) + (size_t)m * DM, (const bf16_t*)(ws + WS_F) + (size_t)m * DM, 1.0f, args.in[17], (float*)(ws + WS_H) + (size_t)m * DM, args.in[18], (bf16_t*)(ws + WS_XN) + (size_t)m * DM, F.lane, (m >= MP) ? (const float*)(ws + WS_SLAB) + (size_t)(m - MP) * DM : nullptr, DM / 256); } SEAM(9);
    if (IN(10)) { pg8::Gemm g{(const bf16_t*)(ws + WS_XN), (const bf16_t*)(ws + WS_WGU2), DM}; pg8::TileOrder S; S.init(MT / 256, 2 * DFF / 256, DM / 64, F.G, bx);
        EpiGU E{(bf16_t*)(ws + WS_ACT)}; pg8::gemm_phase<EpiGU, pg8::TileOrder, true, true>(ring, g, S, E); } SEAM(10);
    if (IN(11)) { pg8::Gemm g{(const bf16_t*)(ws + WS_ACT), (const bf16_t*)(ws + WS_WDN2), DFF}; pg8::PanelOrder S; S.init(DFF / 64, 4, F.G, bx);
        EpiBf16 E{(bf16_t*)(ws + WS_F), DM, (float*)(ws + WS_SLAB), 4}; pg8::gemm_phase<EpiBf16, pg8::PanelOrder, true, true>(ring, g, S, E); } SEAM(11);
    if (IN(12)) { const int gw = F.vcu * NWAVES + F.wave, NGW = F.G * NWAVES;
        for (int m = gw; m < MT; m += NGW) row_update<true, false>((const float*)(ws + WS_H) + (size_t)m * DM, (const bf16_t*)(ws + WS_F) + (size_t)m * DM, 0.5f, args.in[21], args.out + OUT_YP + (size_t)m * DM, nullptr, nullptr, F.lane, (m >= MP) ? (const float*)(ws + WS_SLAB) + (size_t)(m - MP) * DM : nullptr, DFF / 256); }
#undef IN
#undef SEAM
}

constexpr int N_PHASES = 13;
extern "C" void kernel_launch(void* const* d_in, const int* in_sizes, int n_in, void* d_out, int out_size, void* d_ws, size_t ws_size, hipStream_t stream) {
    static int grid = 0;
    if (grid == 0) {
        if (n_in != 22 || (size_t)out_size != OUT_END || ws_size < WS_END) { fprintf(stderr, "kernel_launch: unexpected sizes n_in %d out %d ws %zu\n", n_in, out_size, ws_size); grid = -1; return; }
        int dev = 0, cus = 0, per_cu = 0;
        if (hipGetDevice(&dev) != hipSuccess || hipDeviceGetAttribute(&cus, hipDeviceAttributeMultiprocessorCount, dev) != hipSuccess) { grid = -1; return; }
        if (hipFuncSetAttribute((const void*)mega_fwd, hipFuncAttributeMaxDynamicSharedMemorySize, LDS_BYTES) != hipSuccess) { fprintf(stderr, "kernel_launch: hipFuncSetAttribute failed\n"); grid = -1; return; }
        if (hipOccupancyMaxActiveBlocksPerMultiprocessor(&per_cu, (const void*)mega_fwd, NWAVES * 64, LDS_BYTES) != hipSuccess || per_cu < 1) fprintf(stderr, "kernel_launch: occupancy query says %d\n", per_cu);
        (void)hipGetLastError();
        grid = cus;
    }
    if (grid < 0) return;
    (void)hipMemsetAsync((char*)d_ws + WS_CTL, 0, CTL_ZERO_BYTES, stream);
    Args a{};
    for (int i = 0; i < 22; ++i) a.in[i] = (const float*)d_in[i];
    a.out = (float*)d_out; a.ws = (unsigned char*)d_ws; a.p5mask = 15;
#ifndef PROBE_P5MASK
#define PROBE_P5MASK 15
#endif
    if (PROBE_REP == -1) { a.ph_lo = 0; a.ph_hi = N_PHASES; hipLaunchKernelGGL(mega_fwd, dim3(grid), dim3(NWAVES * 64), LDS_BYTES, stream, a); }
    else for (int p = 0; p < N_PHASES; ++p) for (int r = 0; r < ((p == PROBE_REP) ? 2 : 1); ++r) {
        if (r == 1) (void)hipMemsetAsync((char*)d_ws + WS_CTL + CW_Q * 4, 0, 4096, stream);
        a.ph_lo = p; a.ph_hi = p + 1; a.p5mask = (r == 1) ? PROBE_P5MASK : 15; hipLaunchKernelGGL(mega_fwd, dim3(grid), dim3(NWAVES * 64), LDS_BYTES, stream, a); }
}
```

```cpp
#include <hip/hip_runtime.h>
#include <cstdio>
#include <cstdint>
#ifndef PROBE_REP
#define PROBE_REP -1
#endif

constexpr int DM = 1024, NBATCH = 4, SEQ = 4096, MP = NBATCH * SEQ, DECB = 32, DECS = 8, MS = DECB * DECS, MT = MP + MS;
constexpr int PAST = 8192, PAGE = 128, NPAGES = PAST / PAGE, NPOOL = 2560;
constexpr int SBH = 8, SBD = 64, SBW = 512, RH = 4, RDK = 128, RDV = 256, RQW = 512, RVW = 1024, DFF = 2816, INW = 6656;
constexpr float NORM_EPS = 1e-6f;
constexpr float LOG2E = 1.4426950408889634f;
constexpr size_t OUT_YP = 0, OUT_YS = OUT_YP + (size_t)MP * DM, OUT_KP = OUT_YS + (size_t)MS * DM, OUT_VP = OUT_KP + (size_t)MP * SBW, OUT_SP = OUT_VP + (size_t)MP * SBW,
                 OUT_KS = OUT_SP + (size_t)NBATCH * RH * RDK * RDV, OUT_VS = OUT_KS + (size_t)MS * SBW, OUT_SS = OUT_VS + (size_t)MS * SBW, OUT_END = OUT_SS + (size_t)DECB * RH * RDK * RDV;

#define GAS __attribute__((address_space(1)))
#define LAS __attribute__((address_space(3)))
typedef unsigned short bf16_t;
typedef short bf16x8 __attribute__((ext_vector_type(8)));
typedef short s16x4 __attribute__((ext_vector_type(4)));
typedef float f32x4 __attribute__((ext_vector_type(4)));
typedef float f32x2 __attribute__((ext_vector_type(2)));
typedef float f32x16 __attribute__((ext_vector_type(16)));
typedef unsigned u32x4 __attribute__((ext_vector_type(4)));
typedef unsigned u32x2 __attribute__((ext_vector_type(2)));
typedef GAS unsigned gu32;

__device__ __forceinline__ unsigned cvt_pk_bf16(float lo, float hi) { unsigned r; asm volatile("v_cvt_pk_bf16_f32 %0, %1, %2" : "=v"(r) : "v"(lo), "v"(hi)); return r; }
__device__ __forceinline__ float bf_lo(unsigned w) { return __uint_as_float(w << 16); }
__device__ __forceinline__ float bf_hi(unsigned w) { return __uint_as_float(w & 0xffff0000u); }
__device__ __forceinline__ float fast_rcp(float x) { return __builtin_amdgcn_rcpf(x); }
__device__ __forceinline__ float fast_exp2(float x) { return __builtin_amdgcn_exp2f(x); }
__device__ __forceinline__ float sigmoidf_(float x) { return fast_rcp(1.0f + fast_exp2(-x * LOG2E)); }
__device__ __forceinline__ float siluf_(float x) { return x * sigmoidf_(x); }

namespace pg8 {
constexpr int BM = 256, BK = 64, HALF = 128, HTB = HALF * BK * 2, STAGE_BYTES = 8 * HTB, NXCD = 8, WGM = 8;
__host__ __device__ __forceinline__ int lds_byte(int r, int c) { const int st = (r >> 4) * 2 + (c >> 5), rr = r & 15, cc = c & 31, ob = rr * 64 + cc * 2; return st * 1024 + (ob ^ (((ob >> 9) & 1) << 5)); }
__host__ __device__ __forceinline__ void stage_rc(int b, int& R, int& C) { const int st = b / 1024, sb = b % 1024, swz = sb ^ (((sb >> 9) & 1) << 5); R = (st >> 1) * 16 + swz / 64; C = (st & 1) * 32 + (swz % 64) / 2; }
__host__ __device__ __forceinline__ int perm32(int rho) { const int n = rho >> 4, i = rho & 15; return 8 * (i >> 2) + 4 * n + (i & 3); }

struct Unit { int pm, pn, kt0, nt; };
struct Gemm { const bf16_t* A; const bf16_t* Bt; int K; };

struct TileOrder {
    int nM, nN, nwg, G, c, nt;
    __device__ void init(int nM_, int nN_, int nt_, int G_, int c_) { nM = nM_; nN = nN_; nwg = nM * nN; G = G_; c = c_; nt = nt_; }
    __device__ bool next(int i, Unit& u) const {
        const long L = (long)i * G + c; if (L >= nwg) return false;
        int wgid = (int)L; { const int q = nwg / NXCD, r = nwg % NXCD, xcd = wgid % NXCD, off = wgid / NXCD; wgid = (xcd < r ? xcd * (q + 1) : r * (q + 1) + (xcd - r) * q) + off; }
        const int nig = WGM * nN, gid = wgid / nig, fm = gid * WGM, gsz = (nM - fm) < WGM ? (nM - fm) : WGM;
        u.pm = fm + ((wgid % nig) % gsz); u.pn = (wgid % nig) / gsz; u.kt0 = 0; u.nt = nt; return true;
    }
};

struct PanelOrder {
    TileOrder T; int nex, sl;
    __device__ void init(int nt_, int sl_, int G_, int c_) { T.init(64, 4, nt_, G_, c_); sl = sl_; nex = 4 * (nt_ / sl_); }
    __device__ bool next(int i, Unit& u) const {
        long L = (long)i * T.G + T.c; if (L < 256) return T.next(i, u);
        L -= 256; if (L >= nex) return false;
        u.pm = 64; u.pn = (int)(L & 3); u.kt0 = (int)(L >> 2) * sl; u.nt = sl; return true;
    }
};

template <class Epi, class Sched, bool ALIGN_EPI, bool SP2>
__device__ __forceinline__ void gemm_phase(LAS unsigned char* lds, const Gemm g, const Sched& S, const Epi& E) {
    const int tid = threadIdx.x, wid = __builtin_amdgcn_readfirstlane(tid >> 6), lane = tid & 63, wr = wid >> 2, wc = wid & 3, fr = lane & 15, fq = lane >> 4;
    const int K = g.K;
    unsigned voffA[2], voffB[2];
#pragma unroll
    for (int i = 0; i < 2; ++i) { int R, C; stage_rc(tid * 16 + i * 8192, R, C); const int Rb = (R & ~31) + perm32(R & 31);
        voffA[i] = (unsigned)(R * K + C) * 2u; voffB[i] = (unsigned)(Rb * K + C) * 2u; }
    const size_t kstep = (size_t)(BK * 2);
    const size_t hstep = (size_t)HALF * K * 2;
    const size_t tstep = 2 * hstep;
    const unsigned ldsw = (unsigned)wid * 1024u;
    const int aoff = lds_byte(wr * 64 + fr, fq * 8), boff = lds_byte(wc * 32 + fr, fq * 8);
#define PG8_SA(b, h) (((b) * 2 + (h)) * HTB)
#define PG8_SB(b, h) ((4 + (b) * 2 + (h)) * HTB)
#define PG8_STAGE(bufoff, gbase, voff) do { _Pragma("unroll") for (int _i = 0; _i < 2; ++_i) \
        __builtin_amdgcn_global_load_lds((const unsigned*)((const char*)(gbase) + (voff)[_i]), (LAS unsigned*)(lds + (bufoff) + ldsw + _i * 8192), 16, 0, 0); } while (0)
#define PG8_LDA(dst, b, h) do { _Pragma("unroll") for (int m = 0; m < 4; ++m) _Pragma("unroll") for (int k = 0; k < 2; ++k) dst[m][k] = *(const LAS bf16x8*)(lds + PG8_SA(b, h) + aoff + m * 2048 + k * 1024); } while (0)
#define PG8_LDB(dst, b, h) do { _Pragma("unroll") for (int n = 0; n < 2; ++n) _Pragma("unroll") for (int k = 0; k < 2; ++k) dst[n][k] = *(const LAS bf16x8*)(lds + PG8_SB(b, h) + boff + n * 2048 + k * 1024); } while (0)
#define PG8_MMA(ai, bj, At, Bt) do { __builtin_amdgcn_s_setprio(1); _Pragma("unroll") for (int m = 0; m < 4; ++m) _Pragma("unroll") for (int n = 0; n < 2; ++n) _Pragma("unroll") for (int k = 0; k < 2; ++k) \
        acc[ai][bj][m][n] = __builtin_amdgcn_mfma_f32_16x16x32_bf16(Bt[n][k], At[m][k], acc[ai][bj][m][n], 0, 0, 0); __builtin_amdgcn_s_setprio(0); } while (0)
#define PG8_WAIT_V(n) asm volatile("s_waitcnt vmcnt(" #n ")" ::: "memory")
#define PG8_WAIT_L(n) asm volatile("s_waitcnt lgkmcnt(" #n ")" ::: "memory")
#define PG8_BAR __builtin_amdgcn_s_barrier()
#define PG8_SCHED __builtin_amdgcn_sched_barrier(0)
    Unit cur, nxt; int ui = 0;
    if (!S.next(0, cur)) return;
    f32x4 acc[2][2][4][2];
#pragma unroll
    for (int a = 0; a < 2; ++a)
#pragma unroll
        for (int b = 0; b < 2; ++b)
#pragma unroll
            for (int m = 0; m < 4; ++m)
#pragma unroll
                for (int n = 0; n < 2; ++n) acc[a][b][m][n] = (f32x4){0.f, 0.f, 0.f, 0.f};
    bf16x8 At[4][2], B0[2][2], B1[2][2];
    const char* cA = (const char*)g.A + (size_t)cur.pm * tstep + (size_t)cur.kt0 * kstep; const char* cB = (const char*)g.Bt + (size_t)cur.pn * tstep + (size_t)cur.kt0 * kstep;
    if constexpr (SP2) {
        PG8_STAGE(PG8_SB(0, 0), cB, voffB); PG8_STAGE(PG8_SB(0, 1), cB + hstep, voffB); PG8_STAGE(PG8_SA(0, 0), cA, voffA); PG8_STAGE(PG8_SA(0, 1), cA + hstep, voffA);
        if (wr == 1) PG8_BAR;
        PG8_WAIT_V(2); PG8_BAR;
        PG8_STAGE(PG8_SB(1, 0), cB + kstep, voffB); PG8_STAGE(PG8_SA(1, 0), cA + kstep, voffA); PG8_STAGE(PG8_SB(1, 1), cB + hstep + kstep, voffB);
        PG8_WAIT_V(6); PG8_BAR;
    } else {
        PG8_STAGE(PG8_SB(0, 0), cB, voffB); PG8_STAGE(PG8_SA(0, 0), cA, voffA); PG8_STAGE(PG8_SB(0, 1), cB + hstep, voffB); PG8_STAGE(PG8_SA(0, 1), cA + hstep, voffA);
        if (wr == 1) PG8_BAR;
        PG8_WAIT_V(4); PG8_BAR;
        PG8_STAGE(PG8_SB(1, 0), cB + kstep, voffB); PG8_STAGE(PG8_SA(1, 0), cA + kstep, voffA); PG8_STAGE(PG8_SB(1, 1), cB + hstep + kstep, voffB);
        PG8_WAIT_V(6); PG8_BAR;
    }
    for (;;) {
        const bool has_next = S.next(ui + 1, nxt);
        const char* nA = has_next ? (const char*)g.A + (size_t)nxt.pm * tstep + (size_t)nxt.kt0 * kstep : cA; const char* nB = has_next ? (const char*)g.Bt + (size_t)nxt.pn * tstep + (size_t)nxt.kt0 * kstep : cB;
        const int nt = cur.nt;
        for (int t = 0; t < nt; t += 2) {
            const bool last = (t == nt - 2);
            const char* a1 = cA + (size_t)(t + 1) * kstep;
            const char* a2 = last ? nA : cA + (size_t)(t + 2) * kstep; const char* b2 = last ? nB : cB + (size_t)(t + 2) * kstep;
            const char* a3 = a2 + kstep; const char* b3 = b2 + kstep;
            if constexpr (SP2) {
            PG8_LDB(B0, 0, 0); PG8_LDB(B1, 0, 1); PG8_SCHED; PG8_LDA(At, 0, 0); PG8_STAGE(PG8_SA(1, 1), a1 + hstep, voffA);
            PG8_WAIT_V(8); PG8_WAIT_L(0); PG8_BAR; PG8_MMA(0, 0, At, B0); PG8_MMA(0, 1, At, B1); PG8_BAR; PG8_SCHED;
            PG8_LDA(At, 0, 1); PG8_STAGE(PG8_SB(0, 0), b2, voffB); PG8_STAGE(PG8_SB(0, 1), b2 + hstep, voffB); PG8_STAGE(PG8_SA(0, 0), a2, voffA);
            PG8_WAIT_V(8); PG8_WAIT_L(0); PG8_BAR; PG8_MMA(1, 0, At, B0); PG8_MMA(1, 1, At, B1); PG8_BAR; PG8_SCHED;
            PG8_LDB(B0, 1, 0); PG8_LDB(B1, 1, 1); PG8_SCHED; PG8_LDA(At, 1, 0); PG8_STAGE(PG8_SA(0, 1), a2 + hstep, voffA);
            PG8_WAIT_V(8); PG8_WAIT_L(0); PG8_BAR; PG8_MMA(0, 0, At, B0); PG8_MMA(0, 1, At, B1); PG8_BAR; PG8_SCHED;
            PG8_LDA(At, 1, 1); PG8_STAGE(PG8_SB(1, 0), b3, voffB); PG8_STAGE(PG8_SB(1, 1), b3 + hstep, voffB); PG8_STAGE(PG8_SA(1, 0), a3, voffA);
            PG8_WAIT_V(8); PG8_WAIT_L(0); PG8_BAR; PG8_MMA(1, 0, At, B0); PG8_MMA(1, 1, At, B1); PG8_BAR; PG8_SCHED;
            } else {
            PG8_LDB(B0, 0, 0); PG8_SCHED; PG8_LDA(At, 0, 0); PG8_STAGE(PG8_SA(1, 1), a1 + hstep, voffA);
            PG8_WAIT_L(8); PG8_BAR; PG8_WAIT_L(0); PG8_MMA(0, 0, At, B0); PG8_BAR; PG8_SCHED;
            PG8_LDB(B1, 0, 1); PG8_STAGE(PG8_SB(0, 0), b2, voffB);
            PG8_BAR; PG8_WAIT_L(0); PG8_MMA(0, 1, At, B1); PG8_BAR;
            PG8_LDA(At, 0, 1); PG8_STAGE(PG8_SA(0, 0), a2, voffA);
            PG8_BAR; PG8_WAIT_L(0); PG8_MMA(1, 0, At, B0); PG8_BAR; PG8_SCHED;
            PG8_STAGE(PG8_SB(0, 1), b2 + hstep, voffB);
            PG8_WAIT_V(6); PG8_BAR; PG8_MMA(1, 1, At, B1); PG8_BAR;
            PG8_LDB(B0, 1, 0); PG8_SCHED; PG8_LDA(At, 1, 0); PG8_STAGE(PG8_SA(0, 1), a2 + hstep, voffA);
            PG8_WAIT_L(8); PG8_BAR; PG8_WAIT_L(0); PG8_MMA(0, 0, At, B0); PG8_BAR; PG8_SCHED;
            PG8_LDB(B1, 1, 1); PG8_STAGE(PG8_SB(1, 0), b3, voffB);
            PG8_BAR; PG8_WAIT_L(0); PG8_MMA(0, 1, At, B1); PG8_BAR;
            PG8_LDA(At, 1, 1); PG8_STAGE(PG8_SA(1, 0), a3, voffA);
            PG8_BAR; PG8_WAIT_L(0); PG8_MMA(1, 0, At, B0); PG8_BAR; PG8_SCHED;
            PG8_STAGE(PG8_SB(1, 1), b3 + hstep, voffB);
            PG8_WAIT_V(6); PG8_BAR; PG8_MMA(1, 1, At, B1); PG8_BAR;
            }
        }
        if constexpr (ALIGN_EPI) { if (wr == 0) PG8_BAR; }
        E(acc, cur, wr, wc, fr, fq);
        if (!has_next) break;
#pragma unroll
        for (int a = 0; a < 2; ++a)
#pragma unroll
            for (int b = 0; b < 2; ++b)
#pragma unroll
                for (int m = 0; m < 4; ++m)
#pragma unroll
                    for (int n = 0; n < 2; ++n) acc[a][b][m][n] = (f32x4){0.f, 0.f, 0.f, 0.f};
        cur = nxt; cA = nA; cB = nB; ++ui;
        if constexpr (ALIGN_EPI) { if (wr == 1) PG8_BAR; }
    }
    PG8_WAIT_V(0);
    if constexpr (!ALIGN_EPI) { if (wr == 0) PG8_BAR; }
    PG8_BAR;
#undef PG8_SA
#undef PG8_SB
#undef PG8_STAGE
#undef PG8_LDA
#undef PG8_LDB
#undef PG8_MMA
#undef PG8_WAIT_V
#undef PG8_WAIT_L
#undef PG8_BAR
#undef PG8_SCHED
}
}

constexpr size_t MiB = 1u << 20;
constexpr size_t WS_CTL = 0, CTL_ZERO_BYTES = 1 * MiB;
constexpr size_t WS_TAB = 1 * MiB;
constexpr size_t WS_WGU1 = 4 * MiB;
constexpr size_t WS_WDN1 = 15 * MiB;
constexpr size_t WS_WIN = 21 * MiB;
constexpr size_t WS_WSBO = 34 * MiB;
constexpr size_t WS_WRO = 35 * MiB;
constexpr size_t WS_WO = 37 * MiB;
constexpr size_t WS_WGU2 = 39 * MiB;
constexpr size_t WS_WDN2 = 50 * MiB;
constexpr size_t WS_XN = 56 * MiB;
constexpr size_t WS_ACT = 90 * MiB;
constexpr size_t WS_F = 180 * MiB;
constexpr size_t WS_H = 214 * MiB;
constexpr size_t WS_QSB = 280 * MiB, WS_KSB = 297 * MiB, WS_VSB = 314 * MiB;
constexpr size_t WS_QD = 331 * MiB, WS_KI = 348 * MiB;
constexpr size_t WS_VR = 365 * MiB, WS_GR = 398 * MiB, WS_GA = 431 * MiB, WS_GB = 464 * MiB;
constexpr size_t WS_OSB = 497 * MiB;
constexpr size_t WS_OR = 514 * MiB;
constexpr size_t WS_T1 = 547 * MiB;
constexpr size_t WS_MB = 580 * MiB;
constexpr size_t WS_SPT = 613 * MiB;
constexpr size_t WS_DPART = 646 * MiB;
constexpr size_t WS_SLAB = 700 * MiB;
constexpr size_t WS_END = 720 * MiB;

constexpr int CW_BAR = 4096, CW_Q = 8192;

constexpr int RING_OFF = 0, RING_BYTES = 131072;
constexpr int LDSCTL_OFF = RING_BYTES, MISC_OFF = LDSCTL_OFF + 320;
constexpr int LDS_BYTES = 147456;
constexpr int NWAVES = 8;

#define RLX_AGENT __ATOMIC_RELAXED, __HIP_MEMORY_SCOPE_AGENT
#define LDS_WAIT() asm volatile("s_waitcnt lgkmcnt(0)" ::: "memory")
#define VM_WAIT() asm volatile("s_waitcnt vmcnt(0)" ::: "memory")

#define XB_TMO      128
#define XB_XCNT(j)  (256  + 64 * (j))
#define XB_XSUB(j)  (1280 + 64 * (j))
#define XB_XGEN(j)  (2304 + 64 * (j))
#define XB_TOP      3328
#define XB_TOPGEN   3392
#define XCD_BAR_WORDS 3456
#define XB_SPIN_CAP (1u << 18)
__device__ __forceinline__ unsigned xb_ld(unsigned* p)              { return __hip_atomic_load(p, __ATOMIC_RELAXED, __HIP_MEMORY_SCOPE_AGENT); }
__device__ __forceinline__ unsigned xb_add(unsigned* p, unsigned v) { return __hip_atomic_fetch_add(p, v, __ATOMIC_RELAXED, __HIP_MEMORY_SCOPE_AGENT); }
__device__ __forceinline__ unsigned xb_xcc_id() { return (unsigned)__builtin_amdgcn_s_getreg((3 << 11) | 20) & 0xFu; }
#define XB_SPIN(cond, bar) do { unsigned _sp = 0; while (cond) { __builtin_amdgcn_s_sleep(1); \
    if ((++_sp & 255u) == 0u) { if (xb_ld(&(bar)[XB_TMO])) break; if (_sp > XB_SPIN_CAP) { atomicAdd(&(bar)[XB_TMO], 1u); break; } } } } while (0)
struct XcdBarrier { unsigned* bar; unsigned x; volatile LAS unsigned* st; };
__device__ __forceinline__ XcdBarrier xcd_barrier_post(unsigned* bar, volatile LAS unsigned* st) {
    XcdBarrier b; b.bar = bar; b.x = xb_xcc_id(); b.st = st;
    if (threadIdx.x == 0) (void)xb_add(&bar[XB_XCNT(b.x)], 1u);
    return b;
}
__device__ __forceinline__ void xcd_barrier_complete(unsigned* bar, unsigned x, unsigned& nloc, unsigned& nx) {
    const unsigned G = gridDim.x * gridDim.y * gridDim.z;
    unsigned sum, cnt, mine, sp = 0u;
    for (;;) {
        sum = 0u; cnt = 0u; mine = 0u;
#pragma unroll
        for (unsigned j = 0; j < 16; ++j) { const unsigned c = xb_ld(&bar[XB_XCNT(j)]); sum += c; cnt += (c > 0u) ? 1u : 0u; mine = (j == x) ? c : mine; }
        if (sum == G) break;
        __builtin_amdgcn_s_sleep(1);
        if ((++sp & 255u) == 0u) { if (xb_ld(&bar[XB_TMO])) break; if (sp > XB_SPIN_CAP) { atomicAdd(&bar[XB_TMO], 1u); break; } }
    }
    nloc = mine > 0u ? mine : 1u; nx = cnt > 0u ? cnt : 1u;
}
__device__ __forceinline__ void xcd_barrier(const XcdBarrier& b) {
    asm volatile("s_waitcnt vmcnt(0)" ::: "memory");
    __syncthreads();
    if (threadIdx.x == 0) {
        unsigned* bar = b.bar;
        __builtin_amdgcn_s_waitcnt(0);
        unsigned nloc = b.st[0], nx = b.st[1];
        if (nloc == 0u) { xcd_barrier_complete(bar, b.x, nloc, nx); b.st[0] = nloc; b.st[1] = nx; }
        const unsigned old = xb_add(&bar[XB_XSUB(b.x)], 1u);
        const unsigned gen = old / nloc;
        if (old + 1u == (gen + 1u) * nloc) {
            __builtin_amdgcn_fence(__ATOMIC_RELEASE, "agent");
            asm volatile("s_waitcnt vmcnt(0)" ::: "memory");
            const unsigned og = xb_add(&bar[XB_TOP], 1u);
            const unsigned tg = og / nx;
            if (og + 1u == (tg + 1u) * nx) xb_add(&bar[XB_TOPGEN], 1u);
            else XB_SPIN(xb_ld(&bar[XB_TOPGEN]) == tg, bar);
            __builtin_amdgcn_fence(__ATOMIC_ACQUIRE, "agent");
            xb_add(&bar[XB_XGEN(b.x)], 1u);
            asm volatile("s_waitcnt vmcnt(0)" ::: "memory");
        } else {
            XB_SPIN(xb_ld(&bar[XB_XGEN(b.x)]) == gen, bar);
            __builtin_amdgcn_fence(__ATOMIC_ACQUIRE, "agent");
            asm volatile("s_waitcnt vmcnt(0)" ::: "memory");
        }
    }
    __syncthreads();
}

struct Args { const float* in[22]; float* out; unsigned char* ws; int ph_lo, ph_hi, p5mask, pad; };
struct Frame {
    LAS unsigned char* lds;
    int tid, lane, wave, vcu, G;
};

__device__ __forceinline__ float wave_sum(float v) {
#pragma unroll
    for (int o = 1; o < 64; o <<= 1) v += __shfl_xor(v, o);
    return v;
}
__device__ __forceinline__ unsigned f2bf(float f) { unsigned u = __builtin_bit_cast(unsigned, f); return (u + 0x7fffu + ((u >> 16) & 1u)) >> 16; }
__device__ __forceinline__ unsigned pk2(float lo, float hi) { return f2bf(lo) | (f2bf(hi) << 16); }

__device__ __forceinline__ void p0_transpose_item(const float* W, int K, int N, bf16_t* WT, int drow0, int scol0, int k0, LAS float* scr, int lane) {
#pragma unroll 8
    for (int i = 0; i < 32; ++i) { const int kk = 2 * i + (lane >> 5); scr[kk * 33 + (lane & 31)] = W[(size_t)(k0 + kk) * N + scol0 + (lane & 31)]; }
    LDS_WAIT(); asm volatile("" ::: "memory");
    const int c = lane & 7;
#pragma unroll
    for (int j = 0; j < 4; ++j) { const int n = (lane >> 3) + 8 * j; const LAS float* s = scr + (8 * c) * 33 + n;
        u32x4 o; o.x = pk2(s[0 * 33], s[1 * 33]); o.y = pk2(s[2 * 33], s[3 * 33]); o.z = pk2(s[4 * 33], s[5 * 33]); o.w = pk2(s[6 * 33], s[7 * 33]);
        *(GAS u32x4*)(WT + (size_t)(drow0 + n) * K + k0 + 8 * c) = o; }
    LDS_WAIT(); asm volatile("" ::: "memory");
}
__device__ __forceinline__ int gu_src(int n) { const int p = n >> 8, j = n & 255; return (j < 128) ? 128 * p + j : DFF + 128 * p + (j - 128); }
__device__ __forceinline__ int in_src(int n) {
    if (n < 1536 || n >= 2560) return n;
    const int base = (n < 2048) ? 1536 : 2048, r = n - base, p = r >> 8, j = r & 255, head = 2 * p + ((j >> 6) & 1), half = j >> 7, i = j & 63;
    return base + head * 128 + half * 64 + i;
}

template <int NR, bool HAS_F, bool WRITE_XN, bool BASE_BF16, bool OUT_BF16>
__device__ __forceinline__ void rows_update(const void* base, const bf16_t* f, float coef, const float* gpost, void* out, const float* gpre, bf16_t* xn, size_t rs, int lane, const float* slabrow = nullptr, int nsl = 0) {
    f32x4 v[NR][4], fv[NR][4];
#pragma unroll
    for (int r = 0; r < NR; ++r)
#pragma unroll
        for (int j = 0; j < 4; ++j) {
            if constexpr (BASE_BF16) { const u32x2 w = ((const GAS u32x2*)((const bf16_t*)base + r * rs))[lane + 64 * j]; v[r][j] = (f32x4){bf_lo(w.x), bf_hi(w.x), bf_lo(w.y), bf_hi(w.y)}; }
            else v[r][j] = ((const GAS f32x4*)((const float*)base + r * rs))[lane + 64 * j]; }
    if constexpr (HAS_F) {
        float s[NR];
#pragma unroll
        for (int r = 0; r < NR; ++r) { s[r] = 0.f;
#pragma unroll
            for (int j = 0; j < 4; ++j) {
                if (NR == 1 && slabrow != nullptr) { f32x4 a = {0.f, 0.f, 0.f, 0.f}; for (int k = 0; k < nsl; ++k) a += ((const GAS f32x4*)(slabrow + (size_t)k * 256 * 1024))[lane + 64 * j]; fv[r][j] = a; }
                else { const u32x2 w = ((const GAS u32x2*)(f + r * rs))[lane + 64 * j]; fv[r][j] = (f32x4){bf_lo(w.x), bf_hi(w.x), bf_lo(w.y), bf_hi(w.y)}; }
                s[r] += (fv[r][j].x * fv[r][j].x + fv[r][j].y * fv[r][j].y) + (fv[r][j].z * fv[r][j].z + fv[r][j].w * fv[r][j].w); } }
#pragma unroll
        for (int o = 1; o < 64; o <<= 1)
#pragma unroll
            for (int r = 0; r < NR; ++r) s[r] += __shfl_xor(s[r], o);
#pragma unroll
        for (int r = 0; r < NR; ++r) { const float rstd = coef * (1.0f / sqrtf(s[r] * (1.f / DM) + NORM_EPS));
#pragma unroll
            for (int j = 0; j < 4; ++j) { const f32x4 gp = ((const GAS f32x4*)gpost)[lane + 64 * j]; v[r][j] = v[r][j] + fv[r][j] * rstd * gp;
                if constexpr (OUT_BF16) { u32x2 w; w.x = cvt_pk_bf16(v[r][j].x, v[r][j].y); w.y = cvt_pk_bf16(v[r][j].z, v[r][j].w); ((GAS u32x2*)((bf16_t*)out + r * rs))[lane + 64 * j] = w; }
                else ((GAS f32x4*)((float*)out + r * rs))[lane + 64 * j] = v[r][j]; } }
    }
    if constexpr (WRITE_XN) {
        float s2[NR];
#pragma unroll
        for (int r = 0; r < NR; ++r) { s2[r] = 0.f;
#pragma unroll
            for (int j = 0; j < 4; ++j) s2[r] += (v[r][j].x * v[r][j].x + v[r][j].y * v[r][j].y) + (v[r][j].z * v[r][j].z + v[r][j].w * v[r][j].w); }
#pragma unroll
        for (int o = 1; o < 64; o <<= 1)
#pragma unroll
            for (int r = 0; r < NR; ++r) s2[r] += __shfl_xor(s2[r], o);
#pragma unroll
        for (int r = 0; r < NR; ++r) { const float r2 = 1.0f / sqrtf(s2[r] * (1.f / DM) + NORM_EPS);
#pragma unroll
            for (int j = 0; j < 4; ++j) { const f32x4 gp = ((const GAS f32x4*)gpre)[lane + 64 * j]; const f32x4 o = v[r][j] * r2 * gp;
                u32x2 w; w.x = cvt_pk_bf16(o.x, o.y); w.y = cvt_pk_bf16(o.z, o.w); ((GAS u32x2*)(xn + r * rs))[lane + 64 * j] = w; } }
    }
}
template <bool HAS_F, bool WRITE_XN, bool BASE_BF16, bool OUT_BF16>
__device__ __forceinline__ void rows_phase(const Frame& F, const void* baseP, const void* baseS, const bf16_t* f, float coef, const float* gpost, void* outP, void* outS, const float* gpre, bf16_t* xn, const float* slab, int nsl) {
    const int gw = F.vcu * NWAVES + F.wave, NGW = F.G * NWAVES; const size_t rs = (size_t)NGW * DM;
    int m = gw;
    for (; m + NGW < MP; m += 2 * NGW)
        rows_update<2, HAS_F, WRITE_XN, BASE_BF16, OUT_BF16>(BASE_BF16 ? (const void*)((const bf16_t*)baseP + (size_t)m * DM) : (const void*)((const float*)baseP + (size_t)m * DM), f + (size_t)m * DM, coef, gpost,
            OUT_BF16 ? (void*)((bf16_t*)outP + (size_t)m * DM) : (void*)((float*)outP + (size_t)m * DM), gpre, xn + (size_t)m * DM, rs, F.lane);
    for (; m < MP; m += NGW)
        rows_update<1, HAS_F, WRITE_XN, BASE_BF16, OUT_BF16>(BASE_BF16 ? (const void*)((const bf16_t*)baseP + (size_t)m * DM) : (const void*)((const float*)baseP + (size_t)m * DM), f + (size_t)m * DM, coef, gpost,
            OUT_BF16 ? (void*)((bf16_t*)outP + (size_t)m * DM) : (void*)((float*)outP + (size_t)m * DM), gpre, xn + (size_t)m * DM, 0, F.lane);
    for (int ms = gw; ms < MS; ms += NGW)
        rows_update<1, HAS_F, WRITE_XN, BASE_BF16, OUT_BF16>(BASE_BF16 ? (const void*)((const bf16_t*)baseS + (size_t)ms * DM) : (const void*)((const float*)baseS + (size_t)ms * DM), f + (size_t)(MP + ms) * DM, coef, gpost,
            OUT_BF16 ? (void*)((bf16_t*)outS + (size_t)ms * DM) : (void*)((float*)outS + (size_t)ms * DM), gpre, xn + (size_t)(MP + ms) * DM, 0, F.lane, slab ? slab + (size_t)ms * DM : nullptr, nsl);
}

struct EpiGU {
    bf16_t* O;
    __device__ __forceinline__ void operator()(const f32x4 (&acc)[2][2][4][2], const pg8::Unit& u, int wr, int wc, int fr, int fq) const {
        const int row0 = u.pm * 256 + wr * 64 + fr, col0 = u.pn * 128 + wc * 32 + 8 * fq;
#pragma unroll
        for (int ai = 0; ai < 2; ++ai)
#pragma unroll
            for (int m = 0; m < 4; ++m) {
                const f32x4 g0 = acc[ai][0][m][0], g1 = acc[ai][0][m][1], u0 = acc[ai][1][m][0], u1 = acc[ai][1][m][1];
                u32x4 w; w.x = cvt_pk_bf16(siluf_(g0[0]) * u0[0], siluf_(g0[1]) * u0[1]); w.y = cvt_pk_bf16(siluf_(g0[2]) * u0[2], siluf_(g0[3]) * u0[3]);
                w.z = cvt_pk_bf16(siluf_(g1[0]) * u1[0], siluf_(g1[1]) * u1[1]); w.w = cvt_pk_bf16(siluf_(g1[2]) * u1[2], siluf_(g1[3]) * u1[3]);
                *(u32x4*)(O + (size_t)(row0 + ai * 128 + m * 16) * DFF + col0) = w; }
    }
};
struct EpiBf16 {
    bf16_t* O; int ldc; float* slab; int sl;
    __device__ __forceinline__ void operator()(const f32x4 (&acc)[2][2][4][2], const pg8::Unit& u, int wr, int wc, int fr, int fq) const {
        const int row0 = u.pm * 256 + wr * 64 + fr, col0 = u.pn * 256 + wc * 32 + 8 * fq;
        if (slab != nullptr && u.pm == 64) {
            float* sb = slab + (size_t)(u.kt0 / sl) * 256 * 1024 + (size_t)(wr * 64 + fr) * 1024 + col0;
#pragma unroll
            for (int ai = 0; ai < 2; ++ai)
#pragma unroll
                for (int m = 0; m < 4; ++m)
#pragma unroll
                    for (int bj = 0; bj < 2; ++bj) { float* p = sb + (size_t)(ai * 128 + m * 16) * 1024 + bj * 128; *(f32x4*)p = acc[ai][bj][m][0]; *(f32x4*)(p + 4) = acc[ai][bj][m][1]; }
            return; }
#pragma unroll
        for (int ai = 0; ai < 2; ++ai)
#pragma unroll
            for (int m = 0; m < 4; ++m) { bf16_t* rowp = O + (size_t)(row0 + ai * 128 + m * 16) * ldc + col0;
#pragma unroll
                for (int bj = 0; bj < 2; ++bj) { const f32x4 v0 = acc[ai][bj][m][0], v1 = acc[ai][bj][m][1];
                    u32x4 w; w.x = cvt_pk_bf16(v0[0], v0[1]); w.y = cvt_pk_bf16(v0[2], v0[3]); w.z = cvt_pk_bf16(v1[0], v1[1]); w.w = cvt_pk_bf16(v1[2], v1[3]);
                    *(u32x4*)(rowp + bj * 128) = w; } }
    }
};
template <bool ADD> struct EpiGate {
    bf16_t* O; const bf16_t* gate; const bf16_t* T;
    __device__ __forceinline__ void operator()(const f32x4 (&acc)[2][2][4][2], const pg8::Unit& u, int wr, int wc, int fr, int fq) const {
        const int row0 = u.pm * 256 + wr * 64 + fr, col0 = u.pn * 256 + wc * 32 + 8 * fq;
#pragma unroll
        for (int ai = 0; ai < 2; ++ai)
#pragma unroll
            for (int m = 0; m < 4; ++m) { const size_t off = (size_t)(row0 + ai * 128 + m * 16) * DM + col0;
#pragma unroll
                for (int bj = 0; bj < 2; ++bj) { const f32x4 v0 = acc[ai][bj][m][0], v1 = acc[ai][bj][m][1];
                    const u32x4 gw = *(const u32x4*)(gate + off + bj * 128);
                    float o[8] = {v0[0] * bf_lo(gw.x), v0[1] * bf_hi(gw.x), v0[2] * bf_lo(gw.y), v0[3] * bf_hi(gw.y), v1[0] * bf_lo(gw.z), v1[1] * bf_hi(gw.z), v1[2] * bf_lo(gw.w), v1[3] * bf_hi(gw.w)};
                    if constexpr (ADD) { const u32x4 tw = *(const u32x4*)(T + off + bj * 128);
                        o[0] += bf_lo(tw.x); o[1] += bf_hi(tw.x); o[2] += bf_lo(tw.y); o[3] += bf_hi(tw.y); o[4] += bf_lo(tw.z); o[5] += bf_hi(tw.z); o[6] += bf_lo(tw.w); o[7] += bf_hi(tw.w); }
                    u32x4 w; w.x = cvt_pk_bf16(o[0], o[1]); w.y = cvt_pk_bf16(o[2], o[3]); w.z = cvt_pk_bf16(o[4], o[5]); w.w = cvt_pk_bf16(o[6], o[7]);
                    *(u32x4*)(O + off + bj * 128) = w; } }
    }
};
struct EpiIn {
    unsigned char* ws; float* out; const f32x2* tab;
    __device__ __forceinline__ void store8(bf16_t* p, const f32x4& v0, const f32x4& v1, float sc) const {
        u32x4 w; w.x = cvt_pk_bf16(v0[0] * sc, v0[1] * sc); w.y = cvt_pk_bf16(v0[2] * sc, v0[3] * sc); w.z = cvt_pk_bf16(v1[0] * sc, v1[1] * sc); w.w = cvt_pk_bf16(v1[2] * sc, v1[3] * sc);
        *(u32x4*)p = w; }
    __device__ __forceinline__ void operator()(const f32x4 (&acc)[2][2][4][2], const pg8::Unit& u, int wr, int wc, int fr, int fq) const {
        const int row0 = u.pm * 256 + wr * 64 + fr, pn = u.pn, cw = wc * 32 + 8 * fq;
        if (pn < 6) {
            const int which = pn >> 1, colt = (pn & 1) * 256 + cw;
            bf16_t* O = (bf16_t*)(ws + (which == 0 ? WS_QSB : which == 1 ? WS_KSB : WS_VSB));
            const float sc = (which == 0) ? 0.125f * LOG2E : 1.0f;
#pragma unroll
            for (int ai = 0; ai < 2; ++ai)
#pragma unroll
                for (int m = 0; m < 4; ++m) { const int row = row0 + ai * 128 + m * 16;
#pragma unroll
                    for (int bj = 0; bj < 2; ++bj) store8(O + (size_t)row * SBW + colt + bj * 128, acc[ai][bj][m][0], acc[ai][bj][m][1], sc); }
        } else if (pn < 10) {
            const bool isq = pn < 8; const int p = (pn - 6) & 1, head = 2 * p + (wc >> 1), i0 = 32 * (wc & 1) + 8 * fq;
            bf16_t* O = (bf16_t*)(ws + (isq ? WS_QD : WS_KI));
            const float lg = (head == 0) ? -0.04580368961312479f : (head == 1) ? -0.02272007650008353f : (head == 2) ? -0.011315313227834146f : -0.005646563141142063f;
#pragma unroll
            for (int ai = 0; ai < 2; ++ai)
#pragma unroll
                for (int m = 0; m < 4; ++m) { const int row = row0 + ai * 128 + m * 16; const int tpos = (row < MP) ? (row & (SEQ - 1)) : SEQ + ((row - MP) & 7); const int c = tpos & 127;
                    const float sc = isq ? fast_exp2((float)(c + 1) * lg) : 0.08838834764831845f * fast_exp2(-(float)(c + 1) * lg);
                    const f32x4* tp = (const f32x4*)(tab + (size_t)tpos * 64 + i0);
                    const f32x4 t0 = tp[0], t1 = tp[1], t2 = tp[2], t3 = tp[3];
                    const f32x4 a0 = acc[ai][0][m][0], a1 = acc[ai][0][m][1], b0 = acc[ai][1][m][0], b1 = acc[ai][1][m][1];
                    const f32x4 r1a = {a0[0] * t0[0] - b0[0] * t0[1], a0[1] * t0[2] - b0[1] * t0[3], a0[2] * t1[0] - b0[2] * t1[1], a0[3] * t1[2] - b0[3] * t1[3]};
                    const f32x4 r1b = {a1[0] * t2[0] - b1[0] * t2[1], a1[1] * t2[2] - b1[1] * t2[3], a1[2] * t3[0] - b1[2] * t3[1], a1[3] * t3[2] - b1[3] * t3[3]};
                    const f32x4 r2a = {b0[0] * t0[0] + a0[0] * t0[1], b0[1] * t0[2] + a0[1] * t0[3], b0[2] * t1[0] + a0[2] * t1[1], b0[3] * t1[2] + a0[3] * t1[3]};
                    const f32x4 r2b = {b1[0] * t2[0] + a1[0] * t2[1], b1[1] * t2[2] + a1[1] * t2[3], b1[2] * t3[0] + a1[2] * t3[1], b1[3] * t3[2] + a1[3] * t3[3]};
                    bf16_t* rp = O + (size_t)row * RQW + head * 128 + i0;
                    store8(rp, r1a, r1b, sc); store8(rp + 64, r2a, r2b, sc); }
        } else {
            const int which = (pn - 10) >> 2, colt = ((pn - 10) & 3) * 256 + cw;
            bf16_t* O = (bf16_t*)(ws + (which == 0 ? WS_VR : which == 1 ? WS_GR : which == 2 ? WS_GA : WS_GB));
#pragma unroll
            for (int ai = 0; ai < 2; ++ai)
#pragma unroll
                for (int m = 0; m < 4; ++m) { const int row = row0 + ai * 128 + m * 16;
#pragma unroll
                    for (int bj = 0; bj < 2; ++bj) { f32x4 v0 = acc[ai][bj][m][0], v1 = acc[ai][bj][m][1];
                        if (which == 1) { v0 = (f32x4){siluf_(v0[0]), siluf_(v0[1]), siluf_(v0[2]), siluf_(v0[3])}; v1 = (f32x4){siluf_(v1[0]), siluf_(v1[1]), siluf_(v1[2]), siluf_(v1[3])}; }
                        else if (which >= 2) { v0 = (f32x4){sigmoidf_(v0[0]), sigmoidf_(v0[1]), sigmoidf_(v0[2]), sigmoidf_(v0[3])}; v1 = (f32x4){sigmoidf_(v1[0]), sigmoidf_(v1[1]), sigmoidf_(v1[2]), sigmoidf_(v1[3])}; }
                        store8(O + (size_t)row * RVW + colt + bj * 128, v0, v1, 1.0f); } }
        }
    }
};

typedef short v4i16_t __attribute__((ext_vector_type(4)));
#define MFMA32(a, b, c) __builtin_amdgcn_mfma_f32_32x32x16_bf16((a), (b), (c), 0, 0, 0)
__device__ __forceinline__ unsigned imgx(unsigned row) { return ((row & 3u) << 2) | ((row >> 2) & 3u); }
__device__ __forceinline__ unsigned off_b(unsigned row, unsigned ch) { return 256u * row + 16u * (ch ^ imgx(row)); }
__device__ __forceinline__ unsigned row_read_addr(unsigned lane, unsigned row0, unsigned s) { return off_b(row0 + (lane & 31u), 2u * s + (lane >> 5)); }
__device__ __forceinline__ unsigned tr_addr_nat(unsigned lane, unsigned c, unsigned ks, unsigned t) {
    const unsigned h = lane >> 5, blk = (lane >> 4) & 1u, q = (lane & 15u) >> 2, p = lane & 3u;
    return off_b(16u * ks + 8u * h + 4u * t + q, 4u * c + 2u * blk + (p >> 1)) + 8u * (p & 1u); }
__device__ __forceinline__ unsigned tr_addr_acc(unsigned lane, unsigned c, unsigned ks, unsigned t) {
    const unsigned h = lane >> 5, blk = (lane >> 4) & 1u, q = (lane & 15u) >> 2, p = lane & 3u;
    return off_b(16u * ks + 8u * t + 4u * h + q, 4u * c + 2u * blk + (p >> 1)) + 8u * (p & 1u); }
__device__ __forceinline__ s16x4 vtr(const LAS unsigned char* p) { return __builtin_bit_cast(s16x4, __builtin_amdgcn_ds_read_tr16_b64_v4i16((LAS v4i16_t*)p)); }
__device__ __forceinline__ bf16x8 cat8(s16x4 lo, s16x4 hi) { return (bf16x8){lo[0], lo[1], lo[2], lo[3], hi[0], hi[1], hi[2], hi[3]}; }
__device__ __forceinline__ int crow(int r, int hi) { return (r & 3) + 8 * (r >> 2) + 4 * hi; }
__device__ __forceinline__ bf16x8 pack8(const f32x16& x, int s) {
    u32x4 p; p.x = cvt_pk_bf16(x[8 * s], x[8 * s + 1]); p.y = cvt_pk_bf16(x[8 * s + 2], x[8 * s + 3]); p.z = cvt_pk_bf16(x[8 * s + 4], x[8 * s + 5]); p.w = cvt_pk_bf16(x[8 * s + 6], x[8 * s + 7]);
    return __builtin_bit_cast(bf16x8, p); }
__device__ __forceinline__ float ret_lg(int h) { return (h == 0) ? -0.04580368961312479f : (h == 1) ? -0.02272007650008353f : (h == 2) ? -0.011315313227834146f : -0.005646563141142063f; }

template <int ROWS>
__device__ __forceinline__ void ret_stage_dma(LAS unsigned char* stg, const bf16_t* KIt, const bf16_t* VRt, int w, int lane) {
    constexpr int NPK = ROWS / 4, PER = 3 * NPK / 8;
    const unsigned lrow = (unsigned)lane >> 4, lch = (unsigned)lane & 15u;
#pragma unroll
    for (int j = 0; j < PER; ++j) { const int pid = w * PER + j, img = pid / NPK, pc = pid % NPK;
        const unsigned ch = lch ^ ((lrow << 2) | ((unsigned)pc & 3u));
        const char* ub = (img == 0) ? (const char*)(KIt + (size_t)4 * pc * RQW) : (const char*)(VRt + (size_t)4 * pc * RVW + (img - 1) * 128);
        const unsigned voff = (img == 0) ? (lrow * RQW * 2u + ch * 16u) : (lrow * RVW * 2u + ch * 16u);
        __builtin_amdgcn_global_load_lds((const unsigned*)(ub + voff), (LAS unsigned*)(stg + img * (ROWS * 256) + pc * 1024), 16, 0, 0); }
}

__device__ __forceinline__ void ret_scan_unit(const Frame& F, unsigned char* ws, float* out, int bh) {
    const int b = bh >> 2, h = bh & 3, lane = F.lane, w = F.wave, hi = lane >> 5, l31 = lane & 31;
    const bf16_t* KI = (const bf16_t*)(ws + WS_KI) + (size_t)b * SEQ * RQW + h * 128;
    const bf16_t* VR = (const bf16_t*)(ws + WS_VR) + (size_t)b * SEQ * RVW + h * 256;
    bf16_t* SPT = (bf16_t*)(ws + WS_SPT) + (size_t)bh * 32 * 256 * 128;
    LAS unsigned char* ring = F.lds + RING_OFF;
    constexpr int STG = 49152;
    f32x16 S[4];
#pragma unroll
    for (int k = 0; k < 4; ++k)
#pragma unroll
        for (int r = 0; r < 16; ++r) S[k][r] = 0.f;
    const float g128 = fast_exp2(128.0f * ret_lg(h));
    unsigned ka[4][2], va[2];
#pragma unroll
    for (int t = 0; t < 2; ++t) { va[t] = 16384u + (unsigned)(w >> 2) * 16384u + tr_addr_nat(lane, w & 3, 0, t);
#pragma unroll
        for (int kb = 0; kb < 4; ++kb) ka[kb][t] = tr_addr_nat(lane, kb, 0, t); }
    ret_stage_dma<64>(ring, KI, VR, w, lane);
#pragma unroll 1
    for (int i = 0; i < 64; ++i) {
        LAS unsigned char* stg = ring + (i & 1) * STG;
        if (i + 1 < 64) { ret_stage_dma<64>(ring + ((i + 1) & 1) * STG, KI + (size_t)(i + 1) * 64 * RQW, VR + (size_t)(i + 1) * 64 * RVW, w, lane); asm volatile("s_waitcnt vmcnt(6)" ::: "memory"); }
        else asm volatile("s_waitcnt vmcnt(0)" ::: "memory");
        __builtin_amdgcn_s_barrier(); asm volatile("" ::: "memory");
        if ((i & 1) == 0) { bf16_t* sp = SPT + ((size_t)(i >> 1) * 256 + 32 * w + l31) * 128;
#pragma unroll
            for (int kb = 0; kb < 4; ++kb)
#pragma unroll
                for (int g = 0; g < 4; ++g) { u32x2 v; v.x = cvt_pk_bf16(S[kb][4 * g], S[kb][4 * g + 1]); v.y = cvt_pk_bf16(S[kb][4 * g + 2], S[kb][4 * g + 3]);
                    *(u32x2*)(sp + 32 * kb + 8 * g + 4 * hi) = v; } }
#pragma unroll
        for (int ks = 0; ks < 4; ++ks) {
            const bf16x8 bfr = cat8(vtr(stg + va[0] + ks * 4096), vtr(stg + va[1] + ks * 4096));
#pragma unroll
            for (int kb = 0; kb < 4; ++kb) { const bf16x8 afr = cat8(vtr(stg + ka[kb][0] + ks * 4096), vtr(stg + ka[kb][1] + ks * 4096));
                S[kb] = MFMA32(afr, bfr, S[kb]); } }
        if (i & 1) {
#pragma unroll
            for (int kb = 0; kb < 4; ++kb) S[kb] = S[kb] * g128; }
        asm volatile("s_waitcnt lgkmcnt(0)" ::: "memory"); __builtin_amdgcn_s_barrier(); asm volatile("" ::: "memory");
    }
    float* so = out + OUT_SP + (size_t)bh * RDK * RDV + 32 * w + l31;
#pragma unroll
    for (int kb = 0; kb < 4; ++kb)
#pragma unroll
        for (int r = 0; r < 16; ++r) so[(size_t)(32 * kb + crow(r, hi)) * RDV] = S[kb][r];
}

__device__ __forceinline__ void ret_out_unit(const Frame& F, const Args& a, int bh, int n) {
    unsigned char* ws = a.ws;
    const int b = bh >> 2, h = bh & 3, lane = F.lane, w = F.wave, hi = lane >> 5, l31 = lane & 31, cb = w & 3, dvh = w >> 2;
    const size_t row0 = (size_t)b * SEQ + 128 * n;
    LAS unsigned char* ring = F.lds + RING_OFF;
    ret_stage_dma<128>(ring, (const bf16_t*)(ws + WS_KI) + row0 * RQW + h * 128, (const bf16_t*)(ws + WS_VR) + row0 * RVW + h * 256, w, lane);
    const bf16_t* qp = (const bf16_t*)(ws + WS_QD) + (row0 + 32 * cb + l31) * RQW + h * 128 + 8 * hi;
    bf16x8 qf[8];
#pragma unroll
    for (int ks = 0; ks < 8; ++ks) qf[ks] = *(const bf16x8*)(qp + 16 * ks);
    f32x16 o[4];
#pragma unroll
    for (int k = 0; k < 4; ++k)
#pragma unroll
        for (int r = 0; r < 16; ++r) o[k][r] = 0.f;
    const bf16_t* sp = (const bf16_t*)(ws + WS_SPT) + (((size_t)bh * 32 + n) * 256 + dvh * 128 + l31) * 128 + 8 * hi;
#pragma unroll
    for (int dvb = 0; dvb < 4; ++dvb) {
        bf16x8 sf[8];
#pragma unroll
        for (int ks = 0; ks < 8; ++ks) sf[ks] = *(const bf16x8*)(sp + (size_t)dvb * 32 * 128 + 16 * ks);
#pragma unroll
        for (int ks = 0; ks < 8; ++ks) o[dvb] = MFMA32(sf[ks], qf[ks], o[dvb]); }
    asm volatile("s_waitcnt vmcnt(0)" ::: "memory"); __builtin_amdgcn_s_barrier(); asm volatile("" ::: "memory");
    const LAS unsigned char* kimg = ring; const LAS unsigned char* vimg = ring + 32768 + dvh * 32768;
#pragma unroll
    for (int sbk = 0; sbk < 4; ++sbk) {
        if (sbk <= cb) {
            f32x16 X;
#pragma unroll
            for (int r = 0; r < 16; ++r) X[r] = 0.f;
#pragma unroll
            for (int ks = 0; ks < 8; ++ks) { const bf16x8 kf = *(const LAS bf16x8*)(kimg + row_read_addr(lane, 32 * sbk, ks)); X = MFMA32(kf, qf[ks], X); }
            if (sbk == cb) {
#pragma unroll
                for (int r = 0; r < 16; ++r) if (crow(r, hi) > l31) X[r] = 0.f; }
            const bf16x8 pa0 = pack8(X, 0), pa1 = pack8(X, 1);
#pragma unroll
            for (int dvb = 0; dvb < 4; ++dvb) {
                const bf16x8 a0 = cat8(vtr(vimg + tr_addr_acc(lane, dvb, 2 * sbk, 0)), vtr(vimg + tr_addr_acc(lane, dvb, 2 * sbk, 1)));
                const bf16x8 a1 = cat8(vtr(vimg + tr_addr_acc(lane, dvb, 2 * sbk + 1, 0)), vtr(vimg + tr_addr_acc(lane, dvb, 2 * sbk + 1, 1)));
                o[dvb] = MFMA32(a0, pa0, o[dvb]); o[dvb] = MFMA32(a1, pa1, o[dvb]); }
        }
    }
    float ssq = 0.f;
#pragma unroll
    for (int dvb = 0; dvb < 4; ++dvb)
#pragma unroll
        for (int r = 0; r < 16; ++r) ssq += o[dvb][r] * o[dvb][r];
    ssq += __shfl_xor(ssq, 32);
    LAS float* red = (LAS float*)(ring + 98304);
    if (hi == 0) red[w * 32 + l31] = ssq;
    asm volatile("s_waitcnt lgkmcnt(0)" ::: "memory"); __builtin_amdgcn_s_barrier(); asm volatile("" ::: "memory");
    const float tot = red[w * 32 + l31] + red[(w ^ 4) * 32 + l31];
    const float rstd = 1.0f / sqrtf(tot * (1.0f / RDV) + NORM_EPS);
    const size_t row = row0 + 32 * cb + l31;
    const bf16_t* gr = (const bf16_t*)(ws + WS_GR) + row * RVW + h * 256 + dvh * 128 + 4 * hi;
    bf16_t* orp = (bf16_t*)(ws + WS_OR) + row * RVW + h * 256 + dvh * 128 + 4 * hi;
    const float* gn = a.in[13] + h * 256 + dvh * 128 + 4 * hi;
#pragma unroll
    for (int dvb = 0; dvb < 4; ++dvb)
#pragma unroll
        for (int g = 0; g < 4; ++g) { const int d = 32 * dvb + 8 * g; const u32x2 gw = *(const u32x2*)(gr + d); const f32x4 gv = *(const f32x4*)(gn + d);
            u32x2 v; v.x = cvt_pk_bf16(o[dvb][4 * g] * rstd * gv[0] * bf_lo(gw.x), o[dvb][4 * g + 1] * rstd * gv[1] * bf_hi(gw.x));
            v.y = cvt_pk_bf16(o[dvb][4 * g + 2] * rstd * gv[2] * bf_lo(gw.y), o[dvb][4 * g + 3] * rstd * gv[3] * bf_hi(gw.y));
            *(u32x2*)(orp + d) = v; }
    asm volatile("s_waitcnt lgkmcnt(0)" ::: "memory"); __builtin_amdgcn_s_barrier(); asm volatile("" ::: "memory");
}

__device__ __forceinline__ void ret_sample_unit(const Frame& F, const Args& a, int sq, int h) {
    unsigned char* ws = a.ws;
    const int lane = F.lane, w = F.wave, tid = F.tid, dvq = w & 3, dkh = w >> 2, dv = 64 * dvq + lane;
    const size_t row0 = (size_t)MP + sq * 8;
    LAS float* QDt = (LAS float*)(F.lds + RING_OFF); LAS float* KIt = QDt + 1024; LAS float* inner = KIt + 1024; LAS float* red = inner + 64; LAS float* ssb = red + 2 * 8 * 256;
    const bf16_t* QD = (const bf16_t*)(ws + WS_QD) + row0 * RQW + h * 128; const bf16_t* KI = (const bf16_t*)(ws + WS_KI) + row0 * RQW + h * 128;
#pragma unroll
    for (int e = tid; e < 1024; e += 512) { const int c = e >> 7, dk = e & 127; QDt[dk * 8 + c] = __uint_as_float((unsigned)QD[(size_t)c * RQW + dk] << 16); KIt[dk * 8 + c] = __uint_as_float((unsigned)KI[(size_t)c * RQW + dk] << 16); }
    __syncthreads();
    if (w == 0) { const int c = lane >> 3, s = lane & 7; float acc = 0.f; for (int dk = 0; dk < 128; ++dk) acc += QDt[dk * 8 + c] * KIt[dk * 8 + s]; inner[lane] = acc; }
    const bf16_t* VR = (const bf16_t*)(ws + WS_VR) + row0 * RVW + h * 256 + dv;
    float v[8], acc[8];
#pragma unroll
    for (int s = 0; s < 8; ++s) { v[s] = __uint_as_float((unsigned)VR[(size_t)s * RVW] << 16); acc[s] = 0.f; }
    const float g8 = fast_exp2(8.0f * ret_lg(h));
    const float* Sin = a.in[4] + (size_t)(sq * 4 + h) * RDK * RDV + dv; float* Sout = a.out + OUT_SS + (size_t)(sq * 4 + h) * RDK * RDV + dv;
#pragma unroll 4
    for (int dk = 64 * dkh; dk < 64 * dkh + 64; ++dk) {
        const float Sv = Sin[(size_t)dk * RDV];
        const f32x4 q0 = *(const LAS f32x4*)(QDt + dk * 8), q1 = *(const LAS f32x4*)(QDt + dk * 8 + 4), k0 = *(const LAS f32x4*)(KIt + dk * 8), k1 = *(const LAS f32x4*)(KIt + dk * 8 + 4);
        acc[0] += q0[0] * Sv; acc[1] += q0[1] * Sv; acc[2] += q0[2] * Sv; acc[3] += q0[3] * Sv; acc[4] += q1[0] * Sv; acc[5] += q1[1] * Sv; acc[6] += q1[2] * Sv; acc[7] += q1[3] * Sv;
        const float kv = (k0[0] * v[0] + k0[1] * v[1]) + (k0[2] * v[2] + k0[3] * v[3]) + (k1[0] * v[4] + k1[1] * v[5]) + (k1[2] * v[6] + k1[3] * v[7]);
        Sout[(size_t)dk * RDV] = g8 * (Sv + kv);
    }
#pragma unroll
    for (int c = 0; c < 8; ++c) red[(dkh * 8 + c) * 256 + dv] = acc[c];
    __syncthreads();
    float o[8];
    if (dkh == 0) {
#pragma unroll
        for (int c = 0; c < 8; ++c) { float x = red[c * 256 + dv] + red[(8 + c) * 256 + dv];
#pragma unroll
            for (int s = 0; s < 8; ++s) if (s <= c) x += inner[c * 8 + s] * v[s];
            o[c] = x; const float q = wave_sum(x * x); if (lane == 0) ssb[dvq * 8 + c] = q; }
    }
    __syncthreads();
    if (dkh == 0) {
        const float gnv = a.in[13][h * 256 + dv];
        const bf16_t* GR = (const bf16_t*)(ws + WS_GR) + row0 * RVW + h * 256 + dv; bf16_t* OR = (bf16_t*)(ws + WS_OR) + row0 * RVW + h * 256 + dv;
#pragma unroll
        for (int c = 0; c < 8; ++c) { const float tot = (ssb[c] + ssb[8 + c]) + (ssb[16 + c] + ssb[24 + c]); const float rstd = 1.0f / sqrtf(tot * (1.0f / RDV) + NORM_EPS);
            OR[(size_t)c * RVW] = (bf16_t)f2bf(o[c] * rstd * gnv * __uint_as_float((unsigned)GR[(size_t)c * RVW] << 16)); }
    }
    __syncthreads();
}

template <bool ADD = false>
__device__ __forceinline__ void sb_scan(f32x16& p, float& R, int hi, float badd = 0.f) {
    float t[16], w[16];
#pragma unroll
    for (int r = 0; r < 16; ++r) { t[r] = fast_exp2(ADD ? p[r] + badd : p[r]); w[r] = fast_rcp(1.0f + t[r]); }
    float G0[4], G1[4];
#pragma unroll
    for (int g = 0; g < 4; ++g) { const float G = (w[4 * g] * w[4 * g + 1]) * (w[4 * g + 2] * w[4 * g + 3]);
        auto rr = __builtin_amdgcn_permlane32_swap(__float_as_uint(G), __float_as_uint(G), false, false); G0[g] = __uint_as_float(rr[0]); G1[g] = __uint_as_float(rr[1]); }
    const float T0 = G0[0] * G1[0], T1 = G0[1] * G1[1], T2 = G0[2] * G1[2], T3 = G0[3] * G1[3];
    const float U2 = T3, U1 = T3 * T2, U0 = U1 * T1;
    float L[4];
    L[3] = R * (hi ? 1.0f : G1[3]); L[2] = R * U2 * (hi ? 1.0f : G1[2]); L[1] = R * U1 * (hi ? 1.0f : G1[1]); L[0] = R * U0 * (hi ? 1.0f : G1[0]);
#pragma unroll
    for (int g = 0; g < 4; ++g) { float incl = L[g];
#pragma unroll
        for (int i = 3; i >= 0; --i) { incl *= w[4 * g + i]; p[4 * g + i] = t[4 * g + i] * incl; } }
    R = R * U0 * T0;
}
__device__ __forceinline__ void sb_qk(const LAS unsigned char* kslot, const bf16x8 (&qr)[4], const f32x16& binit, float& R, bool mask, int dmask, int lane, bf16x8 (&pa)[4]) {
    const int hi = lane >> 5, r32 = lane & 31;
    const LAS unsigned char* kp = kslot + hi * 1024 + r32 * 16;
    f32x16 p0 = binit, p1 = binit;
#pragma unroll
    for (int d0 = 0; d0 < 4; ++d0) { const bf16x8 k0 = *(const LAS bf16x8*)(kp + d0 * 2048), k1 = *(const LAS bf16x8*)(kp + d0 * 2048 + 512);
        p0 = MFMA32(k0, qr[d0], p0); p1 = MFMA32(k1, qr[d0], p1); }
    if (mask) {
#pragma unroll
        for (int r = 0; r < 16; ++r) { const int kv = dmask + (r & 3) + 8 * (r >> 2); if (kv >= 0) p0[r] = -INFINITY; if (kv + 32 >= 0) p1[r] = -INFINITY; } }
    sb_scan(p1, R, hi); sb_scan(p0, R, hi);
    pa[0] = pack8(p0, 0); pa[1] = pack8(p0, 1); pa[2] = pack8(p1, 0); pa[3] = pack8(p1, 1);
}
__device__ __forceinline__ void sb_pv(const LAS unsigned char* vslot, const bf16x8 (&pa)[4], f32x16 (&o)[2], int lane) {
    const int hi = lane >> 5;
    const LAS unsigned char* vp = vslot + ((lane >> 4) & 1) * 32 + (lane & 3) * 8 + (4 * hi + ((lane & 15) >> 2)) * 64;
#pragma unroll
    for (int d0 = 0; d0 < 2; ++d0) {
        const bf16x8 v0 = cat8(vtr(vp + d0 * 4096), vtr(vp + d0 * 4096 + 512)), v1 = cat8(vtr(vp + d0 * 4096 + 1024), vtr(vp + d0 * 4096 + 1024 + 512));
        const bf16x8 v2 = cat8(vtr(vp + d0 * 4096 + 2048), vtr(vp + d0 * 4096 + 2048 + 512)), v3 = cat8(vtr(vp + d0 * 4096 + 3072), vtr(vp + d0 * 4096 + 3072 + 512));
        o[d0] = MFMA32(pa[0], v0, o[d0]); o[d0] = MFMA32(pa[1], v1, o[d0]); o[d0] = MFMA32(pa[2], v2, o[d0]); o[d0] = MFMA32(pa[3], v3, o[d0]); }
}
__device__ __forceinline__ void sb_tile(const LAS unsigned char* kslot, const LAS unsigned char* vslot, const bf16x8 (&qr)[4], const f32x16& binit, float& R, f32x16 (&o)[2], bool mask, int dmask, int lane) {
    bf16x8 pa[4]; sb_qk(kslot, qr, binit, R, mask, dmask, lane, pa); sb_pv(vslot, pa, o, lane);
}
constexpr int AT_SLOT = 8192, AT_K = 0, AT_V = 3 * AT_SLOT, AT_OST = 6 * AT_SLOT;
__device__ __forceinline__ void sb_unit(const Frame& F, unsigned char* ws, const float* sb_bias, int b, int h, int qb) {
    const int lane = F.lane, r32 = lane & 31, hi = lane >> 5, wid = F.wave;
    const size_t rowbase = (size_t)b * SEQ; const int q0 = qb * 256;
    LAS unsigned char* ring = F.lds + RING_OFF;
    const bf16_t* Qw = (const bf16_t*)(ws + WS_QSB) + (rowbase + q0 + wid * 32) * SBW + h * 64;
    const bf16_t* ksrc = (const bf16_t*)(ws + WS_KSB) + rowbase * SBW + h * 64 + (size_t)lane * SBW + wid * 8;
    const bf16_t* vsrc = (const bf16_t*)(ws + WS_VSB) + rowbase * SBW + h * 64 + (size_t)(16 * (wid & 3) + (lane >> 2)) * SBW + (wid >> 2) * 32 + (lane & 3) * 8;
    bf16x8 qr[4];
#pragma unroll
    for (int d0 = 0; d0 < 4; ++d0) qr[d0] = *(const bf16x8*)(Qw + (size_t)r32 * SBW + d0 * 16 + hi * 8);
    const float bias2 = sb_bias[h] * LOG2E;
    f32x16 binit;
#pragma unroll
    for (int r = 0; r < 16; ++r) binit[r] = bias2;
    asm volatile("" : "+v"(binit));
    f32x16 o[2];
#pragma unroll
    for (int r = 0; r < 16; ++r) { o[0][r] = 0.f; o[1][r] = 0.f; }
    float R = 1.0f;
    const int NT = (q0 + 256) / 64;
#define SB_DMA(t, slot) do { __builtin_amdgcn_global_load_lds((const unsigned*)(ksrc + (size_t)(t) * 64 * SBW), (LAS unsigned*)(ring + AT_K + (slot) * AT_SLOT + wid * 1024), 16, 0, 0); \
                             __builtin_amdgcn_global_load_lds((const unsigned*)(vsrc + (size_t)(t) * 64 * SBW), (LAS unsigned*)(ring + AT_V + (slot) * AT_SLOT + wid * 1024), 16, 0, 0); } while (0)
    SB_DMA(NT - 1, 0); SB_DMA(NT - 2, 1);
    int slot = 0;
#pragma unroll 1
    for (int it = 0; it < NT; ++it) {
        const int t = NT - 1 - it;
        if (it + 1 < NT) asm volatile("s_waitcnt vmcnt(2)" ::: "memory"); else asm volatile("s_waitcnt vmcnt(0)" ::: "memory");
        __builtin_amdgcn_s_barrier(); asm volatile("" ::: "memory");
        if (it + 2 < NT) { const int s2 = (slot == 0) ? 2 : slot - 1; SB_DMA(t - 2, s2); }
        const int qmin = q0 + 32 * wid;
        if (64 * t <= qmin + 30) sb_tile(ring + AT_K + slot * AT_SLOT, ring + AT_V + slot * AT_SLOT, qr, binit, R, o, 64 * t + 63 >= qmin, 64 * t + 4 * hi - (qmin + r32), lane);
        asm volatile("s_waitcnt lgkmcnt(0)" ::: "memory");
        slot = (slot == 2) ? 0 : slot + 1;
    }
#undef SB_DMA
    bf16_t* Ow = (bf16_t*)(ws + WS_OSB) + (rowbase + q0 + wid * 32) * SBW + h * 64;
    LAS bf16_t* stg = (LAS bf16_t*)(ring + AT_OST) + wid * 2048;
#pragma unroll
    for (int r = 0; r < 16; ++r) { const int orow = crow(r, hi);
#pragma unroll
        for (int d0 = 0; d0 < 2; ++d0) stg[orow * 64 + d0 * 32 + r32] = (bf16_t)f2bf(o[d0][r]); }
    asm volatile("s_waitcnt lgkmcnt(0)" ::: "memory");
#pragma unroll
    for (int i = 0; i < 4; ++i) { const int row = i * 8 + (lane >> 3), ch = lane & 7; const u32x4 v = *(const LAS u32x4*)(stg + row * 64 + ch * 8); *(u32x4*)(Ow + (size_t)row * SBW + ch * 8) = v; }
    asm volatile("s_waitcnt lgkmcnt(0)" ::: "memory"); __builtin_amdgcn_s_barrier(); asm volatile("" ::: "memory");
}
__device__ __forceinline__ void sbdec_step(const LAS unsigned char* kslot, const bf16x8 (&qr)[4], float bias2, float& R, bool mask, int dmask, int lane, bf16x8 (&pa)[2]) {
    const int hi = lane >> 5, r32 = lane & 31;
    const LAS unsigned char* kp = kslot + hi * 1024 + r32 * 16;
    f32x16 p;
#pragma unroll
    for (int r = 0; r < 16; ++r) p[r] = 0.f;
#pragma unroll
    for (int d0 = 0; d0 < 4; ++d0) { const bf16x8 k0 = *(const LAS bf16x8*)(kp + d0 * 2048); p = MFMA32(k0, qr[d0], p); }
    if (mask) {
#pragma unroll
        for (int r = 0; r < 16; ++r) { const int kv = dmask + (r & 3) + 8 * (r >> 2); if (kv >= 0) p[r] = -INFINITY; } }
    sb_scan<true>(p, R, hi, bias2);
    pa[0] = pack8(p, 0); pa[1] = pack8(p, 1);
}
__device__ __forceinline__ void sbdec_pv(const LAS unsigned char* vslot, const bf16x8 (&pa)[2], f32x16 (&o)[2], int lane) {
    const int hi = lane >> 5;
    const LAS unsigned char* vp = vslot + ((lane >> 4) & 1) * 32 + (lane & 3) * 8 + (4 * hi + ((lane & 15) >> 2)) * 64;
#pragma unroll
    for (int d0 = 0; d0 < 2; ++d0) {
        const bf16x8 v0 = cat8(vtr(vp + d0 * 4096), vtr(vp + d0 * 4096 + 512)), v1 = cat8(vtr(vp + d0 * 4096 + 1024), vtr(vp + d0 * 4096 + 1024 + 512));
        o[d0] = MFMA32(pa[0], v0, o[d0]); o[d0] = MFMA32(pa[1], v1, o[d0]); }
}
__device__ __forceinline__ void sbdec_unit(const Frame& F, const Args& a, int sq, int c) {
    unsigned char* ws = a.ws;
    const int lane = F.lane, r32 = lane & 31, hi = lane >> 5, h = F.wave;
    LAS unsigned char* kslot = F.lds + RING_OFF + h * 16384; LAS unsigned char* vslot = kslot + 8192;
    const size_t qrow = (size_t)MP + sq * 8;
    bf16x8 qr[4];
#pragma unroll
    for (int d0 = 0; d0 < 4; ++d0) { bf16x8 v = {0, 0, 0, 0, 0, 0, 0, 0}; if (r32 < 8) v = *(const bf16x8*)((const bf16_t*)(ws + WS_QSB) + (qrow + r32) * SBW + h * 64 + d0 * 16 + hi * 8); qr[d0] = v; }
    const float bias2 = a.in[12][h] * LOG2E;
    f32x16 o[2];
#pragma unroll
    for (int r = 0; r < 16; ++r) { o[0][r] = 0.f; o[1][r] = 0.f; }
    float R = 1.0f;
    bf16x8 pa[2];
    if (c == 15) {
        const bf16_t* kn = (const bf16_t*)(ws + WS_KSB) + (qrow + (lane & 7)) * SBW + h * 64; const bf16_t* vn = (const bf16_t*)(ws + WS_VSB) + (qrow + (lane & 7)) * SBW + h * 64;
#pragma unroll
        for (int ch = 0; ch < 8; ++ch) { u32x4 kv = {0u, 0u, 0u, 0u}, vv = {0u, 0u, 0u, 0u}; if (lane < 8) { kv = *(const u32x4*)(kn + ch * 8); vv = *(const u32x4*)(vn + ch * 8); }
            if (lane < 32) { *(LAS u32x4*)(kslot + ch * 1024 + lane * 16) = kv; *(LAS u32x4*)(vslot + (ch >> 2) * 4096 + lane * 64 + (ch & 3) * 16) = vv; } }
        asm volatile("s_waitcnt lgkmcnt(0)" ::: "memory");
        sbdec_step(kslot, qr, bias2, R, true, 4 * hi - r32, lane, pa); sbdec_pv(vslot, pa, o, lane);
        asm volatile("s_waitcnt lgkmcnt(0)" ::: "memory");
    }
    const int* ptab = (const int*)a.in[5] + sq * NPAGES + c * 4;
    const int lrow = lane >> 4, lc = lane & 15;
    const size_t lane_e = ((size_t)lrow * SBH + h) * SBD + lc * 4;
    f32x4 kr[8], vr[8];
#define DEC_LOAD(dst, base, tt_) do { const int page_ = __builtin_amdgcn_readfirstlane(ptab[(tt_) >> 2]); const float* g_ = (base) + ((size_t)page_ * PAGE + ((tt_) & 3) * 32) * SBH * SBD + lane_e; \
        _Pragma("unroll") for (int i = 0; i < 8; ++i) dst[i] = __builtin_nontemporal_load((const f32x4*)(g_ + (size_t)i * 4 * SBH * SBD)); } while (0)
    DEC_LOAD(kr, a.in[2], 15); DEC_LOAD(vr, a.in[3], 15);
#pragma unroll 1
    for (int tt = 15; tt >= 0; --tt) {
#pragma unroll
        for (int i = 0; i < 8; ++i) { const int row = 4 * i + lrow; u32x2 w; w.x = cvt_pk_bf16(kr[i][0], kr[i][1]); w.y = cvt_pk_bf16(kr[i][2], kr[i][3]);
            *(LAS u32x2*)(kslot + (lc >> 1) * 1024 + row * 16 + (lc & 1) * 8) = w; }
        if (tt > 0) DEC_LOAD(kr, a.in[2], tt - 1);
        asm volatile("s_waitcnt lgkmcnt(0)" ::: "memory");
        sbdec_step(kslot, qr, bias2, R, false, 0, lane, pa);
#pragma unroll
        for (int i = 0; i < 8; ++i) { const int row = 4 * i + lrow; u32x2 w; w.x = cvt_pk_bf16(vr[i][0], vr[i][1]); w.y = cvt_pk_bf16(vr[i][2], vr[i][3]);
            *(LAS u32x2*)(vslot + (lc >> 3) * 4096 + row * 64 + (lc & 7) * 8) = w; }
        if (tt > 0) DEC_LOAD(vr, a.in[3], tt - 1);
        asm volatile("s_waitcnt lgkmcnt(0)" ::: "memory");
        sbdec_pv(vslot, pa, o, lane);
        asm volatile("s_waitcnt lgkmcnt(0)" ::: "memory");
    }
#undef DEC_LOAD
    float* part = (float*)(ws + WS_DPART) + ((size_t)((sq * 16 + c) * 8 + h) * 8) * 64;
#pragma unroll
    for (int r = 0; r < 4; ++r)
#pragma unroll
        for (int d0 = 0; d0 < 2; ++d0) part[(size_t)(r + 4 * hi) * 64 + 32 * d0 + r32] = o[d0][r];
    float* pr = (float*)(ws + WS_DPART + 16 * MiB) + (size_t)((sq * 16 + c) * 8 + h) * 8;
    if (lane < 8) pr[lane] = R;
    __syncthreads();
}
__device__ __forceinline__ void sbdec_combine(unsigned char* ws, size_t e) {
    const int d = (int)(e & 63), q = (int)((e >> 6) & 7), h = (int)((e >> 9) & 7), sq = (int)(e >> 12);
    const float* part = (const float*)(ws + WS_DPART); const float* pr = (const float*)(ws + WS_DPART + 16 * MiB);
    float acc = 0.f, f = 1.0f;
#pragma unroll
    for (int c = 15; c >= 0; --c) { const size_t u = (size_t)((sq * 16 + c) * 8 + h) * 8 + q; acc += f * part[u * 64 + d]; f *= pr[u]; }
    ((bf16_t*)(ws + WS_OSB))[((size_t)MP + sq * 8 + q) * SBW + h * 64 + d] = (bf16_t)f2bf(acc);
}

__device__ __forceinline__ void p0_prologue(const Frame& F, const Args& a) {
    LAS float* scr = (LAS float*)(F.lds + RING_OFF + F.wave * 16384);
    const int gw = F.vcu * NWAVES + F.wave, NGW = F.G * NWAVES;
    unsigned char* ws = a.ws;
    constexpr int I_GU = (DM / 64) * (2 * DFF / 32), I_DN = (DFF / 64) * (DM / 32), I_IN = (DM / 64) * (INW / 32), I_SBO = (SBW / 64) * (DM / 32), I_RO = (RVW / 64) * (DM / 32), I_O = (DM / 64) * (DM / 32);
    constexpr int NITEMS = 2 * I_GU + 2 * I_DN + I_IN + I_SBO + I_RO + I_O;
    for (int it = gw; it < NITEMS; it += NGW) {
        int r = it;
        if (r < 2 * I_GU) { const int l = r / I_GU; r -= l * I_GU; const int nb = r % (2 * DFF / 32), kb = r / (2 * DFF / 32);
            p0_transpose_item(a.in[l ? 19 : 7], DM, 2 * DFF, (bf16_t*)(ws + (l ? WS_WGU2 : WS_WGU1)), 32 * nb, gu_src(32 * nb), 64 * kb, scr, F.lane); continue; } r -= 2 * I_GU;
        if (r < 2 * I_DN) { const int l = r / I_DN; r -= l * I_DN; const int nb = r % (DM / 32), kb = r / (DM / 32);
            p0_transpose_item(a.in[l ? 20 : 8], DFF, DM, (bf16_t*)(ws + (l ? WS_WDN2 : WS_WDN1)), 32 * nb, 32 * nb, 64 * kb, scr, F.lane); continue; } r -= 2 * I_DN;
        if (r < I_IN) { const int nb = r % (INW / 32), kb = r / (INW / 32);
            p0_transpose_item(a.in[11], DM, INW, (bf16_t*)(ws + WS_WIN), 32 * nb, in_src(32 * nb), 64 * kb, scr, F.lane); continue; } r -= I_IN;
        if (r < I_SBO) { const int nb = r % (DM / 32), kb = r / (DM / 32);
            p0_transpose_item(a.in[14], SBW, DM, (bf16_t*)(ws + WS_WSBO), 32 * nb, 32 * nb, 64 * kb, scr, F.lane); continue; } r -= I_SBO;
        if (r < I_RO) { const int nb = r % (DM / 32), kb = r / (DM / 32);
            p0_transpose_item(a.in[15], RVW, DM, (bf16_t*)(ws + WS_WRO), 32 * nb, 32 * nb, 64 * kb, scr, F.lane); continue; } r -= I_RO;
        { const int nb = r % (DM / 32), kb = r / (DM / 32);
            p0_transpose_item(a.in[16], DM, DM, (bf16_t*)(ws + WS_WO), 32 * nb, 32 * nb, 64 * kb, scr, F.lane); }
    }
    { f32x2* tab = (f32x2*)(ws + WS_TAB);
      for (int e = gw * 64 + F.lane; e < (SEQ + DECS) * 64; e += NGW * 64) { const int tp = e >> 6, i = e & 63; const int pos = (tp < SEQ) ? tp : PAST + (tp - SEQ);
          const float freq = (float)exp2(-(double)i * (13.287712379549449 / 64.0)); const float ang = (float)pos * freq;
          double x = (double)ang * 0.15915494309189535; x -= floor(x); const float xf = (float)x;
          tab[e] = (f32x2){__builtin_amdgcn_cosf(xf), __builtin_amdgcn_sinf(xf)}; } }
    rows_phase<false, true, false, false>(F, a.in[0], a.in[1], nullptr, 0.f, nullptr, nullptr, nullptr, a.in[6], (bf16_t*)(ws + WS_XN), nullptr, 0);
}

__global__ void __launch_bounds__(NWAVES * 64, 2) mega_fwd(Args args) {
    extern __shared__ __attribute__((aligned(16))) unsigned char lds[];
    Frame F;
    F.lds = (LAS unsigned char*)lds;
    volatile LAS unsigned* MISC = (volatile LAS unsigned*)(F.lds + MISC_OFF);
    F.tid = threadIdx.x; F.lane = F.tid & 63; F.wave = __builtin_amdgcn_readfirstlane(F.tid >> 6);
    F.G = gridDim.x; { const int bx = blockIdx.x; F.vcu = (F.G % 8 == 0) ? (bx % 8) * (F.G / 8) + bx / 8 : bx; }
    unsigned char* ws = args.ws;
    unsigned* ctl = (unsigned*)(ws + WS_CTL);
    for (int u = F.tid; u < (LDS_BYTES - LDSCTL_OFF) / 4; u += NWAVES * 64) ((LAS unsigned*)(F.lds + LDSCTL_OFF))[u] = 0u;
    __syncthreads();
    const int lo = args.ph_lo, hi = args.ph_hi;
    const bool multi = (hi - lo) > 1;
    XcdBarrier bar; bar.bar = ctl + CW_BAR; bar.x = 0; bar.st = nullptr;
    if (multi) bar = xcd_barrier_post(ctl + CW_BAR, MISC + 8);
#define IN(k) (lo <= (k) && (k) < hi)
#define SEAM(k) do { if (IN(k) && IN((k) + 1)) xcd_barrier(bar); } while (0)
    LAS unsigned char* ring = F.lds + RING_OFF;
    const int bx = (int)blockIdx.x;

    if (IN(0)) { p0_prologue(F, args); } SEAM(0);
    if (IN(1)) { pg8::Gemm g{(const bf16_t*)(ws + WS_XN), (const bf16_t*)(ws + WS_WGU1), DM}; pg8::TileOrder S; S.init(MT / 256, 2 * DFF / 256, DM / 64, F.G, bx);
        EpiGU E{(bf16_t*)(ws + WS_ACT)}; pg8::gemm_phase<EpiGU, pg8::TileOrder, true, true>(ring, g, S, E); } SEAM(1);
    if (IN(2)) { pg8::Gemm g{(const bf16_t*)(ws + WS_ACT), (const bf16_t*)(ws + WS_WDN1), DFF}; pg8::PanelOrder S; S.init(DFF / 64, 4, F.G, bx);
        EpiBf16 E{(bf16_t*)(ws + WS_F), DM, (float*)(ws + WS_SLAB), 4}; pg8::gemm_phase<EpiBf16, pg8::PanelOrder, true, true>(ring, g, S, E); } SEAM(2);
    if (IN(3)) { rows_phase<true, true, false, true>(F, args.in[0], args.in[1], (const bf16_t*)(ws + WS_F), 0.5f, args.in[9], (bf16_t*)(ws + WS_H), (bf16_t*)(ws + WS_H) + (size_t)MP * DM, args.in[10], (bf16_t*)(ws + WS_XN), (const float*)(ws + WS_SLAB), DFF / 256); } SEAM(3);
    if (IN(4)) { pg8::Gemm g{(const bf16_t*)(ws + WS_XN), (const bf16_t*)(ws + WS_WIN), DM}; pg8::TileOrder S; S.init(MT / 256, INW / 256, DM / 64, F.G, bx);
        EpiIn E{ws, args.out, (const f32x2*)(ws + WS_TAB)}; pg8::gemm_phase<EpiIn, pg8::TileOrder, true, true>(ring, g, S, E); } SEAM(4);
    if (IN(5)) {
#define GRAB(qi) ({ if (F.tid == 0) MISC[0] = __hip_atomic_fetch_add(ctl + CW_Q + 64 * (qi), 1u, __ATOMIC_RELAXED, __HIP_MEMORY_SCOPE_AGENT); __syncthreads(); \
                    const int u_ = __builtin_amdgcn_readfirstlane((int)MISC[0]); __syncthreads(); u_; })
        const bool roleD = ((bx >> 3) & 15) < 7;
        const int pm5 = args.p5mask;
        if (pm5 & 1) for (;;) { const int u = GRAB(0); if (u >= 16) break; ret_scan_unit(F, ws, args.out, u); }
        if (roleD && (pm5 & 2)) for (;;) { const int u = GRAB(1); if (u >= 512) break; sbdec_unit(F, args, u >> 4, u & 15); }
        if (pm5 & 4) for (;;) { const int u = GRAB(2); if (u >= 512) break; sb_unit(F, ws, args.in[12], (u & 31) >> 3, u & 7, 15 - (u >> 5)); }
        if (!roleD && (pm5 & 2)) for (;;) { const int u = GRAB(1); if (u >= 512) break; sbdec_unit(F, args, u >> 4, u & 15); }
        if (pm5 & 8) for (;;) { const int u = GRAB(3); if (u >= DECB * RH) break; ret_sample_unit(F, args, u >> 2, u & 3); }
#undef GRAB
    } SEAM(5);
    if (IN(6)) { for (int u = F.vcu; u < 512; u += F.G) ret_out_unit(F, args, u >> 5, u & 31);
        for (size_t e = (size_t)bx * 512 + F.tid; e < (size_t)DECB * 8 * 8 * 64; e += (size_t)F.G * 512) sbdec_combine(ws, e); } SEAM(6);
    if (IN(7)) { pg8::Gemm g{(const bf16_t*)(ws + WS_OSB), (const bf16_t*)(ws + WS_WSBO), SBW}; pg8::TileOrder S; S.init(MT / 256, DM / 256, SBW / 64, F.G, bx);
        EpiGate<false> E{(bf16_t*)(ws + WS_T1), (const bf16_t*)(ws + WS_GA), nullptr}; pg8::gemm_phase<EpiGate<false>, pg8::TileOrder, true, true>(ring, g, S, E); }
    if (IN(7)) { pg8::Gemm g{(const bf16_t*)(ws + WS_OR), (const bf16_t*)(ws + WS_WRO), RVW}; pg8::TileOrder S; S.init(MT / 256, DM / 256, RVW / 64, F.G, bx);
        EpiGate<true> E{(bf16_t*)(ws + WS_MB), (const bf16_t*)(ws + WS_GB), (const bf16_t*)(ws + WS_T1)}; pg8::gemm_phase<EpiGate<true>, pg8::TileOrder, true, true>(ring, g, S, E); }
    if (IN(7) && bx >= 8) {
        const size_t nth = (size_t)(F.G - 8) * 512, t0 = (size_t)(bx - 8) * 512 + F.tid; constexpr size_t NCH = (size_t)MT * SBW / 8;
        for (size_t i = t0; i < 2 * NCH; i += nth) { const int which = i >= NCH; const size_t e = (which ? i - NCH : i) * 8;
            const u32x4 w = *(const u32x4*)((const bf16_t*)(ws + (which ? WS_VSB : WS_KSB)) + e);
            float* o = (e < (size_t)MP * SBW) ? args.out + (which ? OUT_VP : OUT_KP) + e : args.out + (which ? OUT_VS : OUT_KS) + (e - (size_t)MP * SBW);
            __builtin_nontemporal_store((f32x4){bf_lo(w.x), bf_hi(w.x), bf_lo(w.y), bf_hi(w.y)}, (f32x4*)o); __builtin_nontemporal_store((f32x4){bf_lo(w.z), bf_hi(w.z), bf_lo(w.w), bf_hi(w.w)}, (f32x4*)(o + 4)); } }
    SEAM(7);
    if (IN(8)) { pg8::Gemm g{(const bf16_t*)(ws + WS_MB), (const bf16_t*)(ws + WS_WO), DM}; pg8::PanelOrder S; S.init(DM / 64, 4, F.G, bx);
        EpiBf16 E{(bf16_t*)(ws + WS_F), DM, (float*)(ws + WS_SLAB), 4}; pg8::gemm_phase<EpiBf16, pg8::PanelOrder, true, true>(ring, g, S, E); } SEAM(8);
    if (IN(9)) { rows_phase<true, true, true, true>(F, (const bf16_t*)(ws + WS_H), (const bf16_t*)(ws + WS_H) + (size_t)MP * DM, (const bf16_t*)(ws + WS_F), 1.0f, args.in[17], (bf16_t*)(ws + WS_H), (bf16_t*)(ws + WS_H) + (size_t)MP * DM, args.in[18], (bf16_t*)(ws + WS_XN), (const float*)(ws + WS_SLAB), DM / 256); } SEAM(9);
    if (IN(10)) { pg8::Gemm g{(const bf16_t*)(ws + WS_XN), (const bf16_t*)(ws + WS_WGU2), DM}; pg8::TileOrder S; S.init(MT / 256, 2 * DFF / 256, DM / 64, F.G, bx);
        EpiGU E{(bf16_t*)(ws + WS_ACT)}; pg8::gemm_phase<EpiGU, pg8::TileOrder, true, true>(ring, g, S, E); } SEAM(10);
    if (IN(11)) { pg8::Gemm g{(const bf16_t*)(ws + WS_ACT), (const bf16_t*)(ws + WS_WDN2), DFF}; pg8::PanelOrder S; S.init(DFF / 64, 4, F.G, bx);
        EpiBf16 E{(bf16_t*)(ws + WS_F), DM, (float*)(ws + WS_SLAB), 4}; pg8::gemm_phase<EpiBf16, pg8::PanelOrder, true, true>(ring, g, S, E); } SEAM(11);
    if (IN(12)) { rows_phase<true, false, true, false>(F, (const bf16_t*)(ws + WS_H), (const bf16_t*)(ws + WS_H) + (size_t)MP * DM, (const bf16_t*)(ws + WS_F), 0.5f, args.in[21], args.out + OUT_YP, args.out + OUT_YS, nullptr, nullptr, (const float*)(ws + WS_SLAB), DFF / 256); }
#ifdef PROBE_XBAR
    if (multi) for (int i_ = 0; i_ < PROBE_XBAR; ++i_) xcd_barrier(bar);
#endif
#undef IN
#undef SEAM
}

constexpr int N_PHASES = 13;
extern "C" void kernel_launch(void* const* d_in, const int* in_sizes, int n_in, void* d_out, int out_size, void* d_ws, size_t ws_size, hipStream_t stream) {
    static int grid = 0;
    if (grid == 0) {
        if (n_in != 22 || (size_t)out_size != OUT_END || ws_size < WS_END) { fprintf(stderr, "kernel_launch: unexpected sizes n_in %d out %d ws %zu\n", n_in, out_size, ws_size); grid = -1; return; }
        int dev = 0, cus = 0, per_cu = 0;
        if (hipGetDevice(&dev) != hipSuccess || hipDeviceGetAttribute(&cus, hipDeviceAttributeMultiprocessorCount, dev) != hipSuccess) { grid = -1; return; }
        if (hipFuncSetAttribute((const void*)mega_fwd, hipFuncAttributeMaxDynamicSharedMemorySize, LDS_BYTES) != hipSuccess) { fprintf(stderr, "kernel_launch: hipFuncSetAttribute failed\n"); grid = -1; return; }
        if (hipOccupancyMaxActiveBlocksPerMultiprocessor(&per_cu, (const void*)mega_fwd, NWAVES * 64, LDS_BYTES) != hipSuccess || per_cu < 1) fprintf(stderr, "kernel_launch: occupancy query says %d\n", per_cu);
        (void)hipGetLastError();
        grid = cus;
    }
    if (grid < 0) return;
    (void)hipMemsetAsync((char*)d_ws + WS_CTL, 0, CTL_ZERO_BYTES, stream);
    Args a{};
    for (int i = 0; i < 22; ++i) a.in[i] = (const float*)d_in[i];
    a.out = (float*)d_out; a.ws = (unsigned char*)d_ws; a.p5mask = 15;
#ifndef PROBE_P5MASK
#define PROBE_P5MASK 15
#endif
    if (PROBE_REP == -1) { a.ph_lo = 0; a.ph_hi = N_PHASES; hipLaunchKernelGGL(mega_fwd, dim3(grid), dim3(NWAVES * 64), LDS_BYTES, stream, a); }
    else for (int p = 0; p < N_PHASES; ++p) for (int r = 0; r < ((p == PROBE_REP) ? 2 : 1); ++r) {
        if (r == 1) (void)hipMemsetAsync((char*)d_ws + WS_CTL + CW_Q * 4, 0, 4096, stream);
        a.ph_lo = p; a.ph_hi = p + 1; a.p5mask = (r == 1) ? PROBE_P5MASK : 15; hipLaunchKernelGGL(mega_fwd, dim3(grid), dim3(NWAVES * 64), LDS_BYTES, stream, a); }
}
```
